# Optimizing an MI355X kernel written in HIP

```python
import math
import jax, jax.numpy as jnp
from jax import lax
import numpy as np

D_MODEL = 2048
BATCH = 8
SEQ = 2048
DEPTH = 4
DEC_BATCH = 4
DEC_SEQ = 4096
PAST_LEN = 128

GRID_W = 64
HEAD_DIM = 128
N_MIXERS = 2
NA_HEADS = D_MODEL // HEAD_DIM
NA_ROWS = 8
NA_COLS = 16
DIL_CONFIG = ((128, 1), (512, 4), (2048, 16))
N_GROUPS = len(DIL_CONFIG)
DIL_HEADS = D_MODEL // (2 * HEAD_DIM)
N_BUCKETS = 32
MAX_DISTANCE = 1024
D_FF = 5632
N_NA_LAYERS = (DEPTH + 1) // 2
N_DIL_LAYERS = DEPTH // 2
ALPHA = (2 * DEPTH) ** 0.25
BETA = (8 * DEPTH) ** -0.25
LN_EPS = 1e-5
NEG_INF = -1e30

kernel_name = "hybrid_na_dilated_macaron_encoder"


def layer_norm(x, g, b):
    xf = x.astype(jnp.float32)
    mu = jnp.mean(xf, axis=-1, keepdims=True)
    var = jnp.mean(jnp.square(xf - mu), axis=-1, keepdims=True)
    y = (xf - mu) * lax.rsqrt(var + LN_EPS) * g.astype(jnp.float32) + b.astype(jnp.float32)
    return y.astype(x.dtype)


def post_norm(x, sub, g, b):
    return layer_norm(ALPHA * x + sub, g, b)


def swiglu(x, w_gate, w_up, w_down):
    return (jax.nn.silu(x @ w_gate) * (x @ w_up)) @ w_down


def t5_bucket(rel):
    half = N_BUCKETS // 2
    max_exact = half // 2
    sign = jnp.where(rel > 0, half, 0)
    n = jnp.abs(rel)
    nf = jnp.maximum(n, 1).astype(jnp.float32)
    large = max_exact + (jnp.log(nf / max_exact) / math.log(MAX_DISTANCE / max_exact)
                         * (half - max_exact)).astype(jnp.int32)
    large = jnp.minimum(large, half - 1)
    return sign + jnp.where(n < max_exact, n, large)


def neighbourhood_mixer(x, w_qkv, w_o, rpb):
    B, T, _ = x.shape
    rows = T // GRID_W
    kh = min(NA_ROWS, rows)
    qkv = (x @ w_qkv).reshape(B, rows, GRID_W, 3, NA_HEADS, HEAD_DIM)
    q, k, v = qkv[:, :, :, 0], qkv[:, :, :, 1], qkv[:, :, :, 2]
    r = jnp.arange(rows)
    row_idx = jnp.clip(r - kh // 2, 0, rows - kh)[:, None] + jnp.arange(kh)[None, :]
    k_rows = k[:, row_idx]
    v_rows = v[:, row_idx].reshape(B, rows, kh * GRID_W, NA_HEADS, HEAD_DIM)
    c = jnp.arange(GRID_W)
    col_start = jnp.clip(c - NA_COLS // 2, 0, GRID_W - NA_COLS)
    col_ok = (c[None, :] >= col_start[:, None]) & (c[None, :] < col_start[:, None] + NA_COLS)
    dr = row_idx - r[:, None] + (NA_ROWS - 1)
    dc = jnp.clip(c[None, :] - c[:, None], -(NA_COLS - 1), NA_COLS - 1) + (NA_COLS - 1)
    bias = rpb[:, dr[:, None, :, None], dc[None, :, None, :]].astype(jnp.float32)
    s = jnp.einsum('brqhd,brawhd->bhrqaw', q, k_rows).astype(jnp.float32) * HEAD_DIM ** -0.5
    s = jnp.where(col_ok[:, None, :], s + bias[None], NEG_INF)
    s = s.reshape(B, NA_HEADS, rows, GRID_W, kh * GRID_W)
    p = jax.nn.softmax(s, axis=-1).astype(v.dtype)
    o = jnp.einsum('bhrqk,brkhd->brqhd', p, v_rows)
    return o.reshape(B, T, NA_HEADS * HEAD_DIM) @ w_o


def banded_attention(q, k, v, radius, bias):
    n, L, H, dh = q.shape
    qb = radius
    kw = qb + 2 * radius
    nb = -(-L // qb)
    lp = nb * qb
    qblk = jnp.pad(q, ((0, 0), (0, lp - L), (0, 0), (0, 0))).reshape(n, nb, qb, H, dh)
    kv_pad = ((0, 0), (radius, lp - L + radius), (0, 0), (0, 0))
    idx = jnp.arange(nb)[:, None] * qb + jnp.arange(kw)[None, :]
    kblk = jnp.pad(k, kv_pad)[:, idx]
    vblk = jnp.pad(v, kv_pad)[:, idx]
    s = jnp.einsum('nbqhd,nbkhd->nhbqk', qblk, kblk).astype(jnp.float32) * dh ** -0.5
    s = s + bias[None, :, None]
    rel = jnp.arange(kw)[None, :] - radius - jnp.arange(qb)[:, None]
    kpos = idx - radius
    valid = ((kpos >= 0) & (kpos < L))[:, None, :] & (jnp.abs(rel) <= radius)[None]
    s = jnp.where(valid[None, None], s, NEG_INF)
    m = jnp.max(s, axis=-1, keepdims=True)
    p = jnp.exp(s - m)
    den = jnp.sum(p, axis=-1, keepdims=True)
    o = jnp.einsum('nhbqk,nbkhd->nbqhd', (p / den).astype(v.dtype), vblk)
    o = o.reshape(n, lp, H, dh)[:, :L]
    lse = (m + jnp.log(den))[..., 0]
    lse = lse.transpose(0, 2, 3, 1).reshape(n, lp, H)[:, :L]
    return o, lse


def dilated_attention(q, k, v, dil, radius, bias):
    B, T, H, dh = q.shape
    L = T // dil

    def to_sub(t):
        return t.reshape(B, L, dil, H, dh).transpose(0, 2, 1, 3, 4).reshape(B * dil, L, H, dh)

    o, lse = banded_attention(to_sub(q), to_sub(k), to_sub(v), radius, bias)
    o = o.reshape(B, dil, L, H, dh).transpose(0, 2, 1, 3, 4).reshape(B, T, H, dh)
    lse = lse.reshape(B, dil, L, H).transpose(0, 2, 1, 3).reshape(B, T, H)
    return o, lse


def dilated_mixer(x, w_qkv, w_o, rel_bias):
    B, T, _ = x.shape
    qkv = (x @ w_qkv).reshape(B, T, N_GROUPS, 3, DIL_HEADS, HEAD_DIM)
    outs, lses = [], []
    for g, (window, dil) in enumerate(DIL_CONFIG):
        radius = window // (2 * dil)
        rel = jnp.arange(3 * radius)[None, :] - radius - jnp.arange(radius)[:, None]
        bias = rel_bias[t5_bucket(rel * dil)][:, :, g * DIL_HEADS:(g + 1) * DIL_HEADS]
        bias = bias.transpose(2, 0, 1).astype(jnp.float32)
        o, lse = dilated_attention(qkv[:, :, g, 0], qkv[:, :, g, 1], qkv[:, :, g, 2], dil, radius, bias)
        outs.append(o)
        lses.append(lse)
    wts = jax.nn.softmax(jnp.stack(lses, axis=0), axis=0)
    o = jnp.sum(wts[..., None].astype(x.dtype) * jnp.stack(outs, axis=0), axis=0)
    return o.reshape(B, T, DIL_HEADS * HEAD_DIM) @ w_o


def trunk(x, ln_g, ln_b, ffn_w_gate, ffn_w_up, ffn_w_down, na_w_qkv, na_w_o, na_rpb,
          dil_w_qkv, dil_w_o, rel_bias):
    for i in range(DEPTH):
        j = i // N_MIXERS
        x = post_norm(x, 0.5 * swiglu(x, ffn_w_gate[i, 0], ffn_w_up[i, 0], ffn_w_down[i, 0]),
                      ln_g[i, 0], ln_b[i, 0])
        if i % N_MIXERS == 0:
            mix = neighbourhood_mixer(x, na_w_qkv[j], na_w_o[j], na_rpb[j])
        else:
            mix = dilated_mixer(x, dil_w_qkv[j], dil_w_o[j], rel_bias)
        x = post_norm(x, mix, ln_g[i, 1], ln_b[i, 1])
        x = post_norm(x, 0.5 * swiglu(x, ffn_w_gate[i, 1], ffn_w_up[i, 1], ffn_w_down[i, 1]),
                      ln_g[i, 2], ln_b[i, 2])
    return x


def setup_inputs(seed: int = 0) -> dict:
    key = jax.random.key(seed)
    ks = jax.random.split(key, 14)

    def nrm(k, shape, scale):
        return jax.random.normal(k, shape, jnp.float32) * scale

    na_width = NA_HEADS * HEAD_DIM
    dil_width = DIL_HEADS * HEAD_DIM
    return {
        "x_prompt": nrm(ks[0], (BATCH, SEQ, D_MODEL), 1.0),
        "x_sample": nrm(ks[1], (DEC_BATCH, DEC_SEQ, D_MODEL), 1.0),
        "ln_g": 1.0 + nrm(ks[2], (DEPTH, 3, D_MODEL), 0.02),
        "ln_b": nrm(ks[3], (DEPTH, 3, D_MODEL), 0.02),
        "ffn_w_gate": nrm(ks[4], (DEPTH, 2, D_MODEL, D_FF), D_MODEL ** -0.5),
        "ffn_w_up": nrm(ks[5], (DEPTH, 2, D_MODEL, D_FF), D_MODEL ** -0.5),
        "ffn_w_down": nrm(ks[6], (DEPTH, 2, D_FF, D_MODEL), BETA * D_FF ** -0.5),
        "na_w_qkv": nrm(ks[7], (N_NA_LAYERS, D_MODEL, 3 * na_width), D_MODEL ** -0.5),
        "na_w_o": nrm(ks[8], (N_NA_LAYERS, na_width, D_MODEL), BETA * na_width ** -0.5),
        "na_rpb": nrm(ks[9], (N_NA_LAYERS, NA_HEADS, 2 * NA_ROWS - 1, 2 * NA_COLS - 1), 0.2),
        "dil_w_qkv": nrm(ks[10], (N_DIL_LAYERS, D_MODEL, N_GROUPS * 3 * dil_width), D_MODEL ** -0.5),
        "dil_w_o": nrm(ks[11], (N_DIL_LAYERS, dil_width, D_MODEL), BETA * dil_width ** -0.5),
        "rel_bias": nrm(ks[12], (N_BUCKETS, N_GROUPS * DIL_HEADS), 0.2),
    }


def reference(x_prompt, x_sample, ln_g, ln_b, ffn_w_gate, ffn_w_up, ffn_w_down, na_w_qkv, na_w_o,
              na_rpb, dil_w_qkv, dil_w_o, rel_bias):
    y_prompt = trunk(x_prompt, ln_g, ln_b, ffn_w_gate, ffn_w_up, ffn_w_down, na_w_qkv, na_w_o,
                     na_rpb, dil_w_qkv, dil_w_o, rel_bias)
    y_sample = trunk(x_sample, ln_g, ln_b, ffn_w_gate, ffn_w_up, ffn_w_down, na_w_qkv, na_w_o,
                     na_rpb, dil_w_qkv, dil_w_o, rel_bias)
    return (y_prompt, y_sample)
```

```cpp
#include <hip/hip_runtime.h>
#include <cstdio>
#include <cstdint>

#define GAS __attribute__((address_space(1)))
#define LAS __attribute__((address_space(3)))
typedef unsigned short bf16_t;
typedef short bf16x8 __attribute__((ext_vector_type(8)));
typedef float f32x4 __attribute__((ext_vector_type(4)));
typedef unsigned u32x4 __attribute__((ext_vector_type(4)));
typedef unsigned u32x2 __attribute__((ext_vector_type(2)));

constexpr int DM = 2048, DFF = 5632;
constexpr int MTOK = 32768, PROMPT_TOK = 16384;
constexpr float ALPHA = 1.6817928305074290f;
constexpr float LN_EPS = 1e-5f;
constexpr float LOG2E = 1.4426950408889634f;
constexpr float QK_SCALE2 = 0.08838834764831845f * 1.4426950408889634f;

__device__ __forceinline__ unsigned cvt_pk_bf16(float lo, float hi) { unsigned r; asm volatile("v_cvt_pk_bf16_f32 %0, %1, %2" : "=v"(r) : "v"(lo), "v"(hi)); return r; }
__device__ __forceinline__ float bf_lo(unsigned w) { return __builtin_bit_cast(float, w << 16); }
__device__ __forceinline__ float bf_hi(unsigned w) { return __builtin_bit_cast(float, w & 0xffff0000u); }
__device__ __forceinline__ int imin(int a, int b) { return a < b ? a : b; }
__device__ __forceinline__ int imax(int a, int b) { return a > b ? a : b; }

namespace pg8 {
constexpr int BM = 256, BK = 64, HALF = 128, HTB = HALF * BK * 2  , STAGE_BYTES = 8 * HTB, NXCD = 8, WGM = 8;
__host__ __device__ __forceinline__ int lds_byte(int r, int c) { const int st = (r >> 4) * 2 + (c >> 5), rr = r & 15, cc = c & 31, ob = rr * 64 + cc * 2; return st * 1024 + (ob ^ (((ob >> 9) & 1) << 5)); }
__host__ __device__ __forceinline__ void stage_rc(int b, int& R, int& C) { const int st = b / 1024, sb = b % 1024, swz = sb ^ (((sb >> 9) & 1) << 5); R = (st >> 1) * 16 + swz / 64; C = (st & 1) * 32 + (swz % 64) / 2; }
__host__ __device__ __forceinline__ int perm32(int rho) { const int n = rho >> 4, i = rho & 15; return 8 * (i >> 2) + 4 * n + (i & 3); }

struct Unit { int pm, pn; };
struct Gemm { const bf16_t* A; int lda; int K; };

struct StaticOrder {
    int nM, nN, nwg, G, c;
    __device__ void init(int M, int N, int G_, int c_) { nM = M / BM; nN = N / BM; nwg = nM * nN; G = G_; c = c_; }
    __device__ bool next(int i, Unit& u) const {
        const long L = (long)i * G + c; if (L >= nwg) return false;
        int wgid = (int)L; { const int q = nwg / NXCD, r = nwg % NXCD, xcd = wgid % NXCD, off = wgid / NXCD; wgid = (xcd < r ? xcd * (q + 1) : r * (q + 1) + (xcd - r) * q) + off; }
        const int nig = WGM * nN, gid = wgid / nig, fm = gid * WGM, gsz = (nM - fm) < WGM ? (nM - fm) : WGM;
        u.pm = fm + ((wgid % nig) % gsz); u.pn = (wgid % nig) / gsz; return true;
    }
};
struct BPlain { const bf16_t* Bt; int ldb; static constexpr int RMUL = 1;
    __device__ __forceinline__ int ld() const { return ldb; }
    __device__ __forceinline__ const char* half(const Unit& u, int hh) const { return (const char*)Bt + (size_t)(u.pn * BM + hh * HALF) * (size_t)ldb * 2; } };
template <int DIL> struct BPermTok { const bf16_t* X; static constexpr int RMUL = DIL;
    __device__ __forceinline__ int ld() const { return DM; }
    __device__ __forceinline__ const char* half(const Unit& u, int hh) const {
        const int p0 = u.pn * BM + hh * HALF; int T, tok0;
        if (p0 < PROMPT_TOK) { T = 2048; tok0 = p0 & ~2047; } else { T = 4096; tok0 = p0 & ~4095; }
        const int pp = p0 - tok0, L = T / DIL, rho = pp / L, l0 = pp - rho * L;
        return (const char*)X + (size_t)(tok0 + l0 * DIL + rho) * (size_t)DM * 2; } };

struct EpiBf16P {
    static constexpr bool PERM = true;
    bf16_t* O; int ldc;
    __device__ __forceinline__ void operator()(const f32x4 (&acc)[2][2][4][2], const Unit& u, int wr, int wc, int fr, int fq) const {
        const int row0 = u.pm * BM + wr * 64 + fr, col0 = u.pn * BM + wc * 32 + 8 * fq;
#pragma unroll
        for (int ai = 0; ai < 2; ++ai)
#pragma unroll
            for (int m = 0; m < 4; ++m) { bf16_t* rowp = O + (size_t)(row0 + ai * HALF + m * 16) * ldc + col0;
#pragma unroll
                for (int bj = 0; bj < 2; ++bj) { const f32x4 v0 = acc[ai][bj][m][0], v1 = acc[ai][bj][m][1];
                    u32x4 w; w.x = cvt_pk_bf16(v0[0], v0[1]); w.y = cvt_pk_bf16(v0[2], v0[3]); w.z = cvt_pk_bf16(v1[0], v1[1]); w.w = cvt_pk_bf16(v1[2], v1[3]);
                    *(u32x4*)(rowp + bj * HALF) = w; } }
    }
};
__device__ __forceinline__ float silu_mul(float g, float u) { return g * u * __builtin_amdgcn_rcpf(1.0f + __builtin_amdgcn_exp2f(-LOG2E * g)); }
struct EpiSwiGLU {
    static constexpr bool PERM = true;
    bf16_t* H; int ldc;
    __device__ __forceinline__ void operator()(const f32x4 (&acc)[2][2][4][2], const Unit& u, int wr, int wc, int fr, int fq) const {
        const int row0 = u.pm * BM + wr * 64 + fr, col0 = u.pn * HALF + wc * 32 + 8 * fq;
#pragma unroll
        for (int ai = 0; ai < 2; ++ai)
#pragma unroll
            for (int m = 0; m < 4; ++m) { bf16_t* rowp = H + (size_t)(row0 + ai * HALF + m * 16) * ldc + col0;
                const f32x4 g0 = acc[ai][0][m][0], g1 = acc[ai][0][m][1], u0 = acc[ai][1][m][0], u1 = acc[ai][1][m][1];
                u32x4 w; w.x = cvt_pk_bf16(silu_mul(g0[0], u0[0]), silu_mul(g0[1], u0[1])); w.y = cvt_pk_bf16(silu_mul(g0[2], u0[2]), silu_mul(g0[3], u0[3]));
                w.z = cvt_pk_bf16(silu_mul(g1[0], u1[0]), silu_mul(g1[1], u1[1])); w.w = cvt_pk_bf16(silu_mul(g1[2], u1[2]), silu_mul(g1[3], u1[3]));
                *(u32x4*)rowp = w; }
    }
};
struct EpiResid {
    static constexpr bool PERM = false;
    float* Y; int ldc; float alpha, s;
    __device__ __forceinline__ void operator()(const f32x4 (&acc)[2][2][4][2], const Unit& u, int wr, int wc, int fr, int fq) const {
        const int row0 = u.pm * BM + wr * 64 + fr, col0 = u.pn * BM + wc * 32 + 4 * fq;
#pragma unroll
        for (int ai = 0; ai < 2; ++ai)
#pragma unroll
            for (int m = 0; m < 4; ++m) { float* rowp = Y + (size_t)(row0 + ai * HALF + m * 16) * ldc + col0;
#pragma unroll
                for (int bj = 0; bj < 2; ++bj)
#pragma unroll
                    for (int n = 0; n < 2; ++n) { float* p = rowp + bj * HALF + n * 16; const f32x4 x = *(const f32x4*)p; *(f32x4*)p = x * alpha + acc[ai][bj][m][n] * s; }
                asm volatile("" ::: "memory"); }
    }
};

template <class Epi, class BS>
__device__ __forceinline__ void gemm_phase(LAS unsigned char* lds, const Gemm g, const BS B, const StaticOrder& S, const Epi& E) {
    int tid = threadIdx.x; asm volatile("" : "+v"(tid));
    const int wid = __builtin_amdgcn_readfirstlane(tid >> 6), lane = tid & 63, wr = wid >> 2, wc = wid & 3, fr = lane & 15, fq = lane >> 4;
    const int K = g.K, nt = K / BK, lda = g.lda, ldb = B.ld();
    unsigned voffA[2], voffB[2];
#pragma unroll
    for (int i = 0; i < 2; ++i) { int R, C; stage_rc(tid * 16 + i * 8192, R, C); const int Rb = Epi::PERM ? ((R & ~31) + perm32(R & 31)) : R;
        voffA[i] = (unsigned)(R * lda + C) * 2u; voffB[i] = (unsigned)(Rb * BS::RMUL * ldb + C) * 2u; }
    const size_t kstep = (size_t)(BK * 2);
    const size_t hstepA = (size_t)HALF * lda * 2;
    const size_t tstepA = 2 * hstepA;
    const unsigned ldsw = (unsigned)wid * 1024u;
    const int aoff = lds_byte(wr * 64 + fr, fq * 8), boff = lds_byte(wc * 32 + fr, fq * 8);
#define PG8_SA(b, h) (((b) * 2 + (h)) * HTB)
#define PG8_SB(b, h) ((4 + (b) * 2 + (h)) * HTB)
#define PG8_STAGE(bufoff, gbase, voff) do { _Pragma("unroll") for (int _i = 0; _i < 2; ++_i) \
        __builtin_amdgcn_global_load_lds((const unsigned*)((const char*)(gbase) + (voff)[_i]), (LAS unsigned*)(lds + (bufoff) + ldsw + _i * 8192), 16, 0, 0); } while (0)
#define PG8_LDA(dst, b, h) do { _Pragma("unroll") for (int m = 0; m < 4; ++m) _Pragma("unroll") for (int k = 0; k < 2; ++k) dst[m][k] = *(const LAS bf16x8*)(lds + PG8_SA(b, h) + aoff + m * 2048 + k * 1024); } while (0)
#define PG8_LDB(dst, b, h) do { _Pragma("unroll") for (int n = 0; n < 2; ++n) _Pragma("unroll") for (int k = 0; k < 2; ++k) dst[n][k] = *(const LAS bf16x8*)(lds + PG8_SB(b, h) + boff + n * 2048 + k * 1024); } while (0)
#define PG8_MMA(ai, bj, At, Bt) do { __builtin_amdgcn_s_setprio(1); _Pragma("unroll") for (int m = 0; m < 4; ++m) _Pragma("unroll") for (int n = 0; n < 2; ++n) _Pragma("unroll") for (int k = 0; k < 2; ++k) \
        acc[ai][bj][m][n] = __builtin_amdgcn_mfma_f32_16x16x32_bf16(Bt[n][k], At[m][k], acc[ai][bj][m][n], 0, 0, 0); __builtin_amdgcn_s_setprio(0); } while (0)
#define PG8_WAIT_V(n) asm volatile("s_waitcnt vmcnt(" #n ")" ::: "memory")
#define PG8_WAIT_L(n) asm volatile("s_waitcnt lgkmcnt(" #n ")" ::: "memory")
#define PG8_BAR __builtin_amdgcn_s_barrier()
#define PG8_SCHED __builtin_amdgcn_sched_barrier(0)
    Unit cur, nxt; int ui = 0;
    if (!S.next(0, cur)) return;
    f32x4 acc[2][2][4][2];
#pragma unroll
    for (int a = 0; a < 2; ++a)
#pragma unroll
        for (int b = 0; b < 2; ++b)
#pragma unroll
            for (int m = 0; m < 4; ++m)
#pragma unroll
                for (int n = 0; n < 2; ++n) acc[a][b][m][n] = (f32x4){0.f, 0.f, 0.f, 0.f};
    bf16x8 At[4][2], B0[2][2], B1[2][2];
    const char* cA = (const char*)g.A + (size_t)cur.pm * tstepA; const char* cB0 = B.half(cur, 0); const char* cB1 = B.half(cur, 1);
    PG8_STAGE(PG8_SB(0, 0), cB0, voffB); PG8_STAGE(PG8_SB(0, 1), cB1, voffB); PG8_STAGE(PG8_SA(0, 0), cA, voffA); PG8_STAGE(PG8_SA(0, 1), cA + hstepA, voffA);
    if (wr == 1) PG8_BAR;
    PG8_WAIT_V(2); PG8_BAR;
    PG8_STAGE(PG8_SB(1, 0), cB0 + kstep, voffB); PG8_STAGE(PG8_SA(1, 0), cA + kstep, voffA); PG8_STAGE(PG8_SB(1, 1), cB1 + kstep, voffB);
    PG8_WAIT_V(6); PG8_BAR;
    for (;;) {
        const bool has_next = S.next(ui + 1, nxt);
        const char* nA = has_next ? (const char*)g.A + (size_t)nxt.pm * tstepA : cA;
        const char* nB0 = has_next ? B.half(nxt, 0) : cB0; const char* nB1 = has_next ? B.half(nxt, 1) : cB1;
        for (int t = 0; t < nt; t += 2) {
            const bool last = (t == nt - 2);
            const char* a1 = cA + (size_t)(t + 1) * kstep;
            const char* a2 = last ? nA : cA + (size_t)(t + 2) * kstep;
            const char* b20 = last ? nB0 : cB0 + (size_t)(t + 2) * kstep; const char* b21 = last ? nB1 : cB1 + (size_t)(t + 2) * kstep;
            const char* a3 = a2 + kstep; const char* b30 = b20 + kstep; const char* b31 = b21 + kstep;
            PG8_LDB(B0, 0, 0); PG8_LDB(B1, 0, 1); PG8_SCHED; PG8_LDA(At, 0, 0); PG8_STAGE(PG8_SA(1, 1), a1 + hstepA, voffA);
            PG8_WAIT_V(8); PG8_WAIT_L(0); PG8_BAR; PG8_MMA(0, 0, At, B0); PG8_MMA(0, 1, At, B1); PG8_BAR; PG8_SCHED;
            PG8_LDA(At, 0, 1); PG8_STAGE(PG8_SB(0, 0), b20, voffB); PG8_STAGE(PG8_SB(0, 1), b21, voffB); PG8_STAGE(PG8_SA(0, 0), a2, voffA);
            PG8_WAIT_V(8); PG8_WAIT_L(0); PG8_BAR; PG8_MMA(1, 0, At, B0); PG8_MMA(1, 1, At, B1); PG8_BAR; PG8_SCHED;
            PG8_LDB(B0, 1, 0); PG8_LDB(B1, 1, 1); PG8_SCHED; PG8_LDA(At, 1, 0); PG8_STAGE(PG8_SA(0, 1), a2 + hstepA, voffA);
            PG8_WAIT_V(8); PG8_WAIT_L(0); PG8_BAR; PG8_MMA(0, 0, At, B0); PG8_MMA(0, 1, At, B1); PG8_BAR; PG8_SCHED;
            PG8_LDA(At, 1, 1); PG8_STAGE(PG8_SB(1, 0), b30, voffB); PG8_STAGE(PG8_SB(1, 1), b31, voffB); PG8_STAGE(PG8_SA(1, 0), a3, voffA);
            PG8_WAIT_V(8); PG8_WAIT_L(0); PG8_BAR; PG8_MMA(1, 0, At, B0); PG8_MMA(1, 1, At, B1); PG8_BAR; PG8_SCHED;
        }
        if (wr == 0) PG8_BAR;
        E(acc, cur, wr, wc, fr, fq);
        if (!has_next) break;
#pragma unroll
        for (int a = 0; a < 2; ++a)
#pragma unroll
            for (int b = 0; b < 2; ++b)
#pragma unroll
                for (int m = 0; m < 4; ++m)
#pragma unroll
                    for (int n = 0; n < 2; ++n) acc[a][b][m][n] = (f32x4){0.f, 0.f, 0.f, 0.f};
        cur = nxt; cA = nA; cB0 = nB0; cB1 = nB1; ++ui;
        if (wr == 1) PG8_BAR;
    }
    PG8_WAIT_V(0);
    PG8_BAR;
#undef PG8_SA
#undef PG8_SB
#undef PG8_STAGE
#undef PG8_LDA
#undef PG8_LDB
#undef PG8_MMA
#undef PG8_WAIT_V
#undef PG8_WAIT_L
#undef PG8_BAR
#undef PG8_SCHED
}
}

constexpr size_t MiB = 1u << 20;
constexpr size_t WS_CTL = 0, CTL_ZERO_BYTES = 1 * MiB;
constexpr size_t SZ_WGU1 = (size_t)2 * DFF * DM * 2, SZ_WD1 = (size_t)DM * DFF * 2;
constexpr size_t SZ_NAQKV1 = (size_t)3 * DM * DM * 2, SZ_NAO1 = (size_t)DM * DM * 2;
constexpr size_t SZ_DQKV1 = (size_t)9216 * DM * 2, SZ_DO1 = (size_t)DM * 1024 * 2;
constexpr size_t WS_WGU = 2 * MiB;
constexpr size_t WS_WD = WS_WGU + 8 * SZ_WGU1;
constexpr size_t WS_NAQKV = WS_WD + 8 * SZ_WD1;
constexpr size_t WS_NAO = WS_NAQKV + 2 * SZ_NAQKV1;
constexpr size_t WS_DQKV = WS_NAO + 2 * SZ_NAO1;
constexpr size_t WS_DO = WS_DQKV + 2 * SZ_DQKV1;
constexpr size_t WS_XB = WS_DO + 2 * SZ_DO1;
constexpr size_t WS_BIG = WS_XB + (size_t)MTOK * DM * 2;
constexpr size_t SZ_BIG = (size_t)MTOK * 6144 * 2 + (size_t)3 * 1024 * MTOK * 2;
constexpr size_t WS_LSE = WS_BIG + SZ_BIG;
constexpr size_t WS_END = WS_LSE + (size_t)MTOK * 24 * 4;
static_assert((size_t)MTOK * DFF * 2 <= SZ_BIG && (size_t)MTOK * 4096 * 2 + (size_t)DM * MTOK * 2 <= SZ_BIG, "big buffer");
constexpr int CW_BAR = 4096;

constexpr int RING_BYTES = 131072;
constexpr int MISC_OFF = RING_BYTES + 320;
constexpr int LDS_BYTES = 147456;
constexpr int NWAVES = 8;

#define RLX_AGENT __ATOMIC_RELAXED, __HIP_MEMORY_SCOPE_AGENT
#define LDS_WAIT() asm volatile("s_waitcnt lgkmcnt(0)" ::: "memory")

#define XB_TMO      128
#define XB_XCNT(j)  (256  + 64 * (j))
#define XB_XSUB(j)  (1280 + 64 * (j))
#define XB_XGEN(j)  (2304 + 64 * (j))
#define XB_TOP      3328
#define XB_TOPGEN   3392
#define XCD_BAR_WORDS 3456
#define XB_SPIN_CAP (1u << 20)

__device__ __forceinline__ unsigned xb_ld(unsigned* p)              { return __hip_atomic_load(p, __ATOMIC_RELAXED, __HIP_MEMORY_SCOPE_AGENT); }
__device__ __forceinline__ unsigned xb_add(unsigned* p, unsigned v) { return __hip_atomic_fetch_add(p, v, __ATOMIC_RELAXED, __HIP_MEMORY_SCOPE_AGENT); }
__device__ __forceinline__ unsigned xb_xcc_id() { return (unsigned)__builtin_amdgcn_s_getreg((3 << 11) | 20) & 0xFu; }
#define XB_SPIN(cond, bar) do { unsigned _sp = 0; while (cond) { __builtin_amdgcn_s_sleep(1); \
    if ((++_sp & 255u) == 0u) { if (xb_ld(&(bar)[XB_TMO])) break; if (_sp > XB_SPIN_CAP) { atomicAdd(&(bar)[XB_TMO], 1u); break; } } } } while (0)

struct XcdBarrier { unsigned* bar; unsigned x; volatile LAS unsigned* st; };

__device__ __forceinline__ XcdBarrier xcd_barrier_post(unsigned* bar, volatile LAS unsigned* st) {
    XcdBarrier b; b.bar = bar; b.x = xb_xcc_id(); b.st = st;
    if (threadIdx.x == 0) (void)xb_add(&bar[XB_XCNT(b.x)], 1u);
    return b;
}
__device__ __forceinline__ void xcd_barrier_complete(unsigned* bar, unsigned x, unsigned& nloc, unsigned& nx) {
    const unsigned G = gridDim.x * gridDim.y * gridDim.z;
    unsigned sum, cnt, mine, sp = 0u;
    for (;;) {
        sum = 0u; cnt = 0u; mine = 0u;
#pragma unroll
        for (unsigned j = 0; j < 16; ++j) { const unsigned c = xb_ld(&bar[XB_XCNT(j)]); sum += c; cnt += (c > 0u) ? 1u : 0u; mine = (j == x) ? c : mine; }
        if (sum == G) break;
        __builtin_amdgcn_s_sleep(1);
        if ((++sp & 255u) == 0u) { if (xb_ld(&bar[XB_TMO])) break; if (sp > XB_SPIN_CAP) { atomicAdd(&bar[XB_TMO], 1u); break; } }
    }
    nloc = mine > 0u ? mine : 1u; nx = cnt > 0u ? cnt : 1u;
}
__device__ __forceinline__ void xcd_barrier(const XcdBarrier& b) {
    asm volatile("s_waitcnt vmcnt(0)" ::: "memory");
    __syncthreads();
    if (threadIdx.x == 0) {
        unsigned* bar = b.bar;
        __builtin_amdgcn_s_waitcnt(0);
        unsigned nloc = b.st[0], nx = b.st[1];
        if (nloc == 0u) { xcd_barrier_complete(bar, b.x, nloc, nx); b.st[0] = nloc; b.st[1] = nx; }
        const unsigned old = xb_add(&bar[XB_XSUB(b.x)], 1u);
        const unsigned gen = old / nloc;
        if (old + 1u == (gen + 1u) * nloc) {
            __builtin_amdgcn_fence(__ATOMIC_RELEASE, "agent");
            asm volatile("s_waitcnt vmcnt(0)" ::: "memory");
            const unsigned og = xb_add(&bar[XB_TOP], 1u);
            const unsigned tg = og / nx;
            if (og + 1u == (tg + 1u) * nx) xb_add(&bar[XB_TOPGEN], 1u);
            else XB_SPIN(xb_ld(&bar[XB_TOPGEN]) == tg, bar);
            __builtin_amdgcn_fence(__ATOMIC_ACQUIRE, "agent");
            xb_add(&bar[XB_XGEN(b.x)], 1u);
            asm volatile("s_waitcnt vmcnt(0)" ::: "memory");
        } else {
            XB_SPIN(xb_ld(&bar[XB_XGEN(b.x)]) == gen, bar);
            __builtin_amdgcn_fence(__ATOMIC_ACQUIRE, "agent");
            asm volatile("s_waitcnt vmcnt(0)" ::: "memory");
        }
    }
    __syncthreads();
}

__device__ __forceinline__ float wave_sum(float v) {
#pragma unroll
    for (int o = 1; o < 64; o <<= 1) v += __shfl_xor(v, o);
    return v;
}
__device__ __forceinline__ void transpose_item(const float* W, int K, int N, bf16_t* WT, int drow0, int k0, int n0, LAS float* scr, int lane) {
#pragma unroll 8
    for (int i = 0; i < 32; ++i) { const int kk = 2 * i + (lane >> 5); scr[kk * 33 + (lane & 31)] = W[(size_t)(k0 + kk) * N + n0 + (lane & 31)]; }
    LDS_WAIT(); asm volatile("" ::: "memory");
    const int c = lane & 7;
#pragma unroll
    for (int j = 0; j < 4; ++j) { const int n = (lane >> 3) + 8 * j; const LAS float* s = scr + (8 * c) * 33 + n;
        u32x4 o; o.x = cvt_pk_bf16(s[0 * 33], s[1 * 33]); o.y = cvt_pk_bf16(s[2 * 33], s[3 * 33]); o.z = cvt_pk_bf16(s[4 * 33], s[5 * 33]); o.w = cvt_pk_bf16(s[6 * 33], s[7 * 33]);
        *(GAS u32x4*)(WT + (size_t)(drow0 + n) * K + k0 + 8 * c) = o; }
    LDS_WAIT(); asm volatile("" ::: "memory");
}

struct Args { const float* in[13]; float* out; unsigned char* ws; };

__device__ const unsigned char T5_BUCKET[3][65] = {
 {0, 1, 2, 3, 4, 5, 6, 7, 8, 8, 8, 8, 8, 8, 8, 9, 9, 9, 9, 9, 9, 9, 9, 9, 9, 9, 9, 10, 10, 10, 10, 10, 10, 10, 10, 10, 10, 10, 10, 10, 10, 10, 10, 10, 10, 10, 10, 10, 10, 10, 11, 11, 11, 11, 11, 11, 11, 11, 11, 11, 11, 11, 11, 11, 11},
 {0, 4, 8, 8, 9, 9, 9, 10, 10, 10, 10, 10, 10, 11, 11, 11, 11, 11, 11, 11, 11, 11, 11, 12, 12, 12, 12, 12, 12, 12, 12, 12, 12, 12, 12, 12, 12, 12, 12, 12, 12, 12, 13, 13, 13, 13, 13, 13, 13, 13, 13, 13, 13, 13, 13, 13, 13, 13, 13, 13, 13, 13, 13, 13, 13},
 {0, 9, 10, 10, 11, 11, 12, 12, 12, 12, 12, 13, 13, 13, 13, 13, 13, 13, 13, 13, 14, 14, 14, 14, 14, 14, 14, 14, 14, 14, 14, 14, 14, 14, 14, 15, 15, 15, 15, 15, 15, 15, 15, 15, 15, 15, 15, 15, 15, 15, 15, 15, 15, 15, 15, 15, 15, 15, 15, 15, 15, 15, 15, 15, 15}};

__device__ __forceinline__ bf16x8 pack8(const f32x4 a, const f32x4 b) {
    u32x4 w; w.x = cvt_pk_bf16(a[0], a[1]); w.y = cvt_pk_bf16(a[2], a[3]); w.z = cvt_pk_bf16(b[0], b[1]); w.w = cvt_pk_bf16(b[2], b[3]);
    return __builtin_bit_cast(bf16x8, w);
}
__device__ __forceinline__ bf16x8 join8(const u32x2 a, const u32x2 b) { u32x4 w; w.x = a.x; w.y = a.y; w.z = b.x; w.w = b.y; return __builtin_bit_cast(bf16x8, w); }

__device__ __forceinline__ void na_task(GAS bf16_t* QK, const GAS bf16_t* VT, const LAS float* rp, int tok0, int rows, int r, int qj, int h, int lane) {
    const int q = lane & 15, g = lane >> 4;
    const int rs = imin(imax(r - 4, 0), rows - 8);
    const int kb_lo = qj == 0 ? 0 : qj - 1;
    const bool three = (qj == 1) || (qj == 2);
    GAS bf16_t* qrow = QK + (size_t)(tok0 + r * 64 + 16 * qj + q) * 4096 + h * 128;
    bf16x8 qf[4];
#pragma unroll
    for (int kk = 0; kk < 4; ++kk) qf[kk] = *(const GAS bf16x8*)(qrow + 32 * kk + 8 * g);
    f32x4 s[8][3];
    const GAS bf16_t* kbase = QK + (size_t)(tok0 + rs * 64 + 16 * kb_lo + q) * 4096 + 2048 + h * 128 + 8 * g;
#pragma unroll
    for (int a = 0; a < 8; ++a)
#pragma unroll
        for (int kbi = 0; kbi < 3; ++kbi) {
            f32x4 acc = (f32x4){0.f, 0.f, 0.f, 0.f};
            if (kbi < 2 || three) {
                const GAS bf16_t* kp = kbase + (size_t)(a * 64 + 16 * kbi) * 4096;
#pragma unroll
                for (int kk = 0; kk < 4; ++kk) acc = __builtin_amdgcn_mfma_f32_16x16x32_bf16(*(const GAS bf16x8*)(kp + 32 * kk), qf[kk], acc, 0, 0, 0);
            }
            s[a][kbi] = acc;
        }
    const int cq = 16 * qj + q, cs = imin(imax(cq - 8, 0), 48);
    float mx = -1e30f;
#pragma unroll
    for (int a = 0; a < 8; ++a) {
        const LAS float* rpa = rp + (rs + a - r + 7) * 31;
#pragma unroll
        for (int kbi = 0; kbi < 3; ++kbi)
#pragma unroll
            for (int e = 0; e < 4; ++e) {
                const int ck = 16 * (kb_lo + kbi) + 4 * g + e;
                const bool valid = (kbi < 2 || three) && (ck >= cs) && (ck < cs + 16);
                const int dc = imin(imax(ck - cq + 15, 0), 30);
                const float v = valid ? s[a][kbi][e] * QK_SCALE2 + rpa[dc] : -1e30f;
                s[a][kbi][e] = v; mx = fmaxf(mx, v);
            }
    }
    mx = fmaxf(mx, __shfl_xor(mx, 16)); mx = fmaxf(mx, __shfl_xor(mx, 32));
    float sum = 0.f;
#pragma unroll
    for (int a = 0; a < 8; ++a)
#pragma unroll
        for (int kbi = 0; kbi < 3; ++kbi)
#pragma unroll
            for (int e = 0; e < 4; ++e) { const float p = __builtin_amdgcn_exp2f(s[a][kbi][e] - mx); s[a][kbi][e] = p; sum += p; }
    sum += __shfl_xor(sum, 16); sum += __shfl_xor(sum, 32);
    const float inv = 1.0f / sum;
    f32x4 o[8];
#pragma unroll
    for (int dt = 0; dt < 8; ++dt) o[dt] = (f32x4){0.f, 0.f, 0.f, 0.f};
    const GAS bf16_t* vbase = VT + (size_t)(h * 128 + q) * MTOK + tok0 + rs * 64 + 16 * kb_lo + 4 * g;
#pragma unroll
    for (int c = 0; c < 8; ++c) {
        const bf16x8 pf = pack8(s[c][0], s[c][1]);
        const GAS bf16_t* vp = vbase + c * 64;
#pragma unroll
        for (int dt = 0; dt < 8; ++dt) { const u32x2 x = *(const GAS u32x2*)(vp + (size_t)dt * 16 * MTOK), y = *(const GAS u32x2*)(vp + (size_t)dt * 16 * MTOK + 16);
            o[dt] = __builtin_amdgcn_mfma_f32_16x16x32_bf16(join8(x, y), pf, o[dt], 0, 0, 0); }
    }
    if (three) {
#pragma unroll
        for (int c = 0; c < 4; ++c) {
            const bf16x8 pf = pack8(s[2 * c][2], s[2 * c + 1][2]);
            const GAS bf16_t* vp = vbase + (2 * c) * 64 + 32;
#pragma unroll
            for (int dt = 0; dt < 8; ++dt) { const u32x2 x = *(const GAS u32x2*)(vp + (size_t)dt * 16 * MTOK), y = *(const GAS u32x2*)(vp + (size_t)dt * 16 * MTOK + 64);
                o[dt] = __builtin_amdgcn_mfma_f32_16x16x32_bf16(join8(x, y), pf, o[dt], 0, 0, 0); }
        }
    }
#pragma unroll
    for (int dt = 0; dt < 8; ++dt) { const f32x4 v = o[dt] * inv; u32x2 w; w.x = cvt_pk_bf16(v[0], v[1]); w.y = cvt_pk_bf16(v[2], v[3]);
        *(GAS u32x2*)(qrow + 16 * dt + 4 * g) = w; }
}

__device__ __forceinline__ void dil_task(GAS bf16_t* QK, const GAS bf16_t* VTg, GAS float* LSE, const LAS float* bt, int btok0, int sh, int L, int rho, int l0, int colq, int h, int lsecol, int lane) {
    const int q = lane & 15, g = lane >> 4;
    const int tq = btok0 + ((l0 + q) << sh) + rho;
    GAS bf16_t* qrow = QK + (size_t)tq * 6144 + colq;
    bf16x8 qf[4];
#pragma unroll
    for (int kk = 0; kk < 4; ++kk) qf[kk] = *(const GAS bf16x8*)(qrow + 32 * kk + 8 * g);
    f32x4 s[10];
#pragma unroll
    for (int kb = 0; kb < 9; ++kb) {
        const int lk = imin(imax(l0 - 64 + 16 * kb + q, 0), L - 1);
        const GAS bf16_t* kp = QK + (size_t)(btok0 + (lk << sh) + rho) * 6144 + colq + 1024 + 8 * g;
        f32x4 acc = (f32x4){0.f, 0.f, 0.f, 0.f};
#pragma unroll
        for (int kk = 0; kk < 4; ++kk) acc = __builtin_amdgcn_mfma_f32_16x16x32_bf16(*(const GAS bf16x8*)(kp + 32 * kk), qf[kk], acc, 0, 0, 0);
        s[kb] = acc;
    }
    s[9] = (f32x4){0.f, 0.f, 0.f, 0.f};
    float mx = -1e30f;
#pragma unroll
    for (int kb = 0; kb < 9; ++kb)
#pragma unroll
        for (int e = 0; e < 4; ++e) {
            const int rel = -64 + 16 * kb + 4 * g + e - q, lkey = l0 + q + rel;
            const bool valid = (rel >= -64) && (rel <= 64) && (lkey >= 0) && (lkey < L);
            const int bi = imin(imax(rel + 64, 0), 128);
            const float v = valid ? s[kb][e] * QK_SCALE2 + bt[bi] : -1e30f;
            s[kb][e] = v; mx = fmaxf(mx, v);
        }
    mx = fmaxf(mx, __shfl_xor(mx, 16)); mx = fmaxf(mx, __shfl_xor(mx, 32));
    float sum = 0.f;
#pragma unroll
    for (int kb = 0; kb < 9; ++kb)
#pragma unroll
        for (int e = 0; e < 4; ++e) { const float p = __builtin_amdgcn_exp2f(s[kb][e] - mx); s[kb][e] = p; sum += p; }
    sum += __shfl_xor(sum, 16); sum += __shfl_xor(sum, 32);
    const float inv = 1.0f / sum;
    if (g == 0) LSE[(size_t)tq * 24 + lsecol] = mx + __builtin_amdgcn_logf(sum);
    f32x4 o[8];
#pragma unroll
    for (int dt = 0; dt < 8; ++dt) o[dt] = (f32x4){0.f, 0.f, 0.f, 0.f};
    const GAS bf16_t* vbase = VTg + (size_t)(h * 128 + q) * MTOK + btok0 + rho * L;
#pragma unroll
    for (int c = 0; c < 5; ++c) {
        const bf16x8 pf = pack8(s[2 * c], s[2 * c + 1]);
        const int lx = imin(imax(l0 - 64 + 32 * c + 4 * g, 0), L - 4), ly = imin(imax(l0 - 64 + 32 * c + 16 + 4 * g, 0), L - 4);
#pragma unroll
        for (int dt = 0; dt < 8; ++dt) { const u32x2 x = *(const GAS u32x2*)(vbase + (size_t)dt * 16 * MTOK + lx), y = *(const GAS u32x2*)(vbase + (size_t)dt * 16 * MTOK + ly);
            o[dt] = __builtin_amdgcn_mfma_f32_16x16x32_bf16(join8(x, y), pf, o[dt], 0, 0, 0); }
    }
#pragma unroll
    for (int dt = 0; dt < 8; ++dt) { const f32x4 v = o[dt] * inv; u32x2 w; w.x = cvt_pk_bf16(v[0], v[1]); w.y = cvt_pk_bf16(v[2], v[3]);
        *(GAS u32x2*)(qrow + 16 * dt + 4 * g) = w; }
}

__global__ void __launch_bounds__(NWAVES * 64, 2) fwd(Args args) {
    extern __shared__ __attribute__((aligned(16))) unsigned char lds_raw[];
    LAS unsigned char* lds = (LAS unsigned char*)lds_raw;
    volatile LAS unsigned* MISC = (volatile LAS unsigned*)(lds + MISC_OFF);
    const int G = gridDim.x, bx = blockIdx.x;
    const int vcu = (G % 8 == 0) ? (bx % 8) * (G / 8) + bx / 8 : bx;
    const int NGW = G * NWAVES;
    { const int t0 = threadIdx.x; for (int u = t0; u < (LDS_BYTES - RING_BYTES) / 4; u += NWAVES * 64) ((LAS unsigned*)(lds + RING_BYTES))[u] = 0u; }
    __syncthreads();
    XcdBarrier bar = xcd_barrier_post((unsigned*)(args.ws + WS_CTL) + CW_BAR, MISC + 8);
#define GRID_BAR() xcd_barrier(bar)
#define PHASE_LOCALS() int tid = threadIdx.x; asm volatile("" : "+v"(tid)); const int lane = tid & 63, wave = __builtin_amdgcn_readfirstlane(tid >> 6); const int gw = vcu * NWAVES + wave; \
    unsigned char* ws = args.ws; asm volatile("" : "+s"(ws)); float* out = args.out; asm volatile("" : "+s"(out)); (void)lane; (void)gw; (void)out; \
    bf16_t* WGU = (bf16_t*)(ws + WS_WGU); bf16_t* WD = (bf16_t*)(ws + WS_WD); bf16_t* NAQKV = (bf16_t*)(ws + WS_NAQKV); bf16_t* NAO = (bf16_t*)(ws + WS_NAO); \
    bf16_t* DQKV = (bf16_t*)(ws + WS_DQKV); bf16_t* DOW = (bf16_t*)(ws + WS_DO); bf16_t* XB = (bf16_t*)(ws + WS_XB); bf16_t* BIG = (bf16_t*)(ws + WS_BIG); \
    float* LSE = (float*)(ws + WS_LSE); (void)WGU; (void)WD; (void)NAQKV; (void)NAO; (void)DQKV; (void)DOW; (void)XB; (void)BIG; (void)LSE;

    {
        PHASE_LOCALS();
        LAS float* scr = (LAS float*)(lds + wave * 16384);
        constexpr int NFFN = 24 * 5632, NNAQ = 2 * 6144, NNAO = 2 * 2048, NDQ = 2 * 9216, NDO = 2 * 1024;
        constexpr int NITEMS = NFFN + NNAQ + NNAO + NDQ + NDO;
        for (int it = gw; it < NITEMS; it += NGW) {
            int r = it;
            if (r < NFFN) {
                const int m = r / 5632, rr = r - m * 5632, f = m / 3, kind = m - 3 * f;
                if (kind < 2) { const int kb = rr / 176, nb = rr - kb * 176, n0 = nb * 32;
                    transpose_item(args.in[4 + kind] + (size_t)f * DM * DFF, DM, DFF, WGU + (size_t)f * 2 * DFF * DM, (n0 >> 7) * 256 + (n0 & 127) + kind * 128, kb * 64, n0, scr, lane); }
                else { const int kb = rr / 64, nb = rr - kb * 64, n0 = nb * 32;
                    transpose_item(args.in[6] + (size_t)f * DFF * DM, DFF, DM, WD + (size_t)f * DM * DFF, n0, kb * 64, n0, scr, lane); }
                continue;
            }
            r -= NFFN;
            if (r < NNAQ) { const int j = r / 6144, rr = r - j * 6144, kb = rr / 192, nb = rr - kb * 192, n0 = nb * 32;
                transpose_item(args.in[7] + (size_t)j * DM * 6144, DM, 6144, NAQKV + (size_t)j * 6144 * DM, n0, kb * 64, n0, scr, lane); continue; }
            r -= NNAQ;
            if (r < NNAO) { const int j = r / 2048, rr = r - j * 2048, kb = rr / 64, nb = rr - kb * 64, n0 = nb * 32;
                transpose_item(args.in[8] + (size_t)j * DM * DM, DM, DM, NAO + (size_t)j * DM * DM, n0, kb * 64, n0, scr, lane); continue; }
            r -= NNAO;
            if (r < NDQ) { const int j = r / 9216, rr = r - j * 9216, kb = rr / 288, nb = rr - kb * 288, n0 = nb * 32;
                const int grp = n0 / 3072, rem = n0 - grp * 3072, which = rem >> 10;
                const int drow = which < 2 ? grp * 2048 + rem : 6144 + grp * 1024 + (rem & 1023);
                transpose_item(args.in[10] + (size_t)j * DM * 9216, DM, 9216, DQKV + (size_t)j * 9216 * DM, drow, kb * 64, n0, scr, lane); continue; }
            r -= NDQ;
            { const int j = r / 1024, rr = r - j * 1024, kb = rr / 64, nb = rr - kb * 64, n0 = nb * 32;
                transpose_item(args.in[11] + (size_t)j * 1024 * DM, 1024, DM, DOW + (size_t)j * DM * 1024, n0, kb * 64, n0, scr, lane); }
        }
        for (int m = gw; m < MTOK; m += NGW) {
            const float* src = m < PROMPT_TOK ? args.in[0] + (size_t)m * DM : args.in[1] + (size_t)(m - PROMPT_TOK) * DM;
            const GAS f32x4* xr = (const GAS f32x4*)src + lane; GAS f32x4* orow = (GAS f32x4*)(out + (size_t)m * DM) + lane; GAS u32x2* brow = (GAS u32x2*)(XB + (size_t)m * DM) + lane;
#pragma unroll
            for (int j = 0; j < 8; ++j) { const f32x4 v = xr[64 * j]; orow[64 * j] = v; u32x2 w; w.x = cvt_pk_bf16(v[0], v[1]); w.y = cvt_pk_bf16(v[2], v[3]); brow[64 * j] = w; }
        }
    }
    GRID_BAR();

    for (int sl = 0; sl < 12; ++sl) {
        const int li = sl / 3, kind = sl - 3 * li;
        PHASE_LOCALS();
        const bf16_t* Ares; int lda_res, Kres; const bf16_t* Wres; float sres;
        if (kind != 1) {
            const int f = li * 2 + (kind >> 1);
            { pg8::Gemm g{XB, DM, DM}; pg8::BPlain B{WGU + (size_t)f * 2 * DFF * DM, DM}; pg8::StaticOrder S; S.init(MTOK, 2 * DFF, G, bx); pg8::EpiSwiGLU E{BIG, DFF};
              pg8::gemm_phase<pg8::EpiSwiGLU, pg8::BPlain>(lds, g, B, S, E); }
            GRID_BAR();
            Ares = BIG; lda_res = DFF; Kres = DFF; Wres = WD + (size_t)f * DM * DFF; sres = 0.5f;
        } else if ((li & 1) == 0) {
            const int j = li >> 1;
            bf16_t* QKB = BIG; bf16_t* VTB = BIG + (size_t)MTOK * 4096;
            const bf16_t* W = NAQKV + (size_t)j * 6144 * DM;
            for (int job = 0; job < 2; ++job) {
                pg8::Gemm g; pg8::BPlain B; pg8::StaticOrder S; pg8::EpiBf16P E;
                if (job == 0) { g = pg8::Gemm{XB, DM, DM}; B = pg8::BPlain{W, DM}; S.init(MTOK, 4096, G, bx); E = pg8::EpiBf16P{QKB, 4096}; }
                else { g = pg8::Gemm{W + (size_t)4096 * DM, DM, DM}; B = pg8::BPlain{XB, DM}; S.init(DM, MTOK, G, bx); E = pg8::EpiBf16P{VTB, MTOK}; }
                pg8::gemm_phase<pg8::EpiBf16P, pg8::BPlain>(lds, g, B, S, E);
            }
            GRID_BAR();
            {
                LAS float* rp = (LAS float*)lds;
                const float* rpb = args.in[9] + (size_t)j * 16 * 465;
                for (int id = vcu; id < 4096; id += G) {
                    int tok0, rows, h, pair;
                    if (id < 2048) { const int img = id >> 8, rem = id & 255; h = rem >> 4; pair = rem & 15; rows = 32; tok0 = img * 2048; }
                    else { const int i2 = id - 2048, img = i2 >> 9, rem = i2 & 511; h = rem >> 5; pair = rem & 31; rows = 64; tok0 = PROMPT_TOK + img * 4096; }
                    __syncthreads();
                    if (tid < 465) rp[tid] = rpb[h * 465 + tid] * LOG2E;
                    __syncthreads();
                    na_task((GAS bf16_t*)QKB, (const GAS bf16_t*)VTB, rp, tok0, rows, 2 * pair + (wave >> 2), wave & 3, h, lane);
                }
            }
            GRID_BAR();
            Ares = QKB; lda_res = 4096; Kres = DM; Wres = NAO + (size_t)j * DM * DM; sres = 1.0f;
        } else {
            const int j = li >> 1;
            bf16_t* QKB = BIG; bf16_t* VT0 = BIG + (size_t)MTOK * 6144;
            const bf16_t* W = DQKV + (size_t)j * 9216 * DM;
            for (int job = 0; job < 2; ++job) {
                pg8::Gemm g; pg8::BPlain B; pg8::StaticOrder S; pg8::EpiBf16P E;
                if (job == 0) { g = pg8::Gemm{XB, DM, DM}; B = pg8::BPlain{W, DM}; S.init(MTOK, 6144, G, bx); E = pg8::EpiBf16P{QKB, 6144}; }
                else { g = pg8::Gemm{W + (size_t)6144 * DM, DM, DM}; B = pg8::BPlain{XB, DM}; S.init(1024, MTOK, G, bx); E = pg8::EpiBf16P{VT0, MTOK}; }
                pg8::gemm_phase<pg8::EpiBf16P, pg8::BPlain>(lds, g, B, S, E);
            }
            { pg8::Gemm g{W + (size_t)7168 * DM, DM, DM}; pg8::BPermTok<4> B{XB}; pg8::StaticOrder S; S.init(1024, MTOK, G, bx); pg8::EpiBf16P E{VT0 + (size_t)1024 * MTOK, MTOK};
              pg8::gemm_phase<pg8::EpiBf16P, pg8::BPermTok<4>>(lds, g, B, S, E); }
            { pg8::Gemm g{W + (size_t)8192 * DM, DM, DM}; pg8::BPermTok<16> B{XB}; pg8::StaticOrder S; S.init(1024, MTOK, G, bx); pg8::EpiBf16P E{VT0 + (size_t)2048 * MTOK, MTOK};
              pg8::gemm_phase<pg8::EpiBf16P, pg8::BPermTok<16>>(lds, g, B, S, E); }
            GRID_BAR();
            {
                LAS float* bt = (LAS float*)lds;
                const float* relb = args.in[12];
                for (int id = vcu; id < 6144; id += G) {
                    const int gh = id >> 8, pb = id & 255, grp = gh >> 3, h = gh & 7, sh = 2 * grp;
                    int T, btok0, pp;
                    if (pb < 128) { T = 2048; btok0 = (pb >> 4) * 2048; pp = (pb & 15) * 128; }
                    else { T = 4096; btok0 = PROMPT_TOK + ((pb - 128) >> 5) * 4096; pp = ((pb - 128) & 31) * 128; }
                    const int L = T >> sh, rho = pp / L, l0b = pp - rho * L;
                    __syncthreads();
                    if (tid < 129) { const int rel = tid - 64, mag = rel < 0 ? -rel : rel; const int bucket = (rel > 0 ? 16 : 0) + T5_BUCKET[grp][mag];
                        bt[tid] = relb[bucket * 24 + grp * 8 + h] * LOG2E; }
                    __syncthreads();
                    dil_task((GAS bf16_t*)QKB, (const GAS bf16_t*)(VT0 + (size_t)grp * 1024 * MTOK), (GAS float*)LSE, bt, btok0, sh, L, rho, l0b + 16 * wave, grp * 2048 + h * 128, h, grp * 8 + h, lane);
                }
            }
            GRID_BAR();
            for (int tok = gw; tok < MTOK; tok += NGW) {
                const int h = lane >> 3, c16 = (lane & 7) * 16;
                const GAS float* lp = (const GAS float*)LSE + (size_t)tok * 24 + h;
                const float l0 = lp[0], l1 = lp[8], l2 = lp[16];
                const float m = fmaxf(l0, fmaxf(l1, l2));
                float w0 = __builtin_amdgcn_exp2f(l0 - m), w1 = __builtin_amdgcn_exp2f(l1 - m), w2 = __builtin_amdgcn_exp2f(l2 - m);
                const float inv = 1.0f / (w0 + w1 + w2); w0 *= inv; w1 *= inv; w2 *= inv;
                GAS bf16_t* base = (GAS bf16_t*)QKB + (size_t)tok * 6144 + h * 128 + c16;
#pragma unroll
                for (int hf = 0; hf < 2; ++hf) {
                    const u32x4 a0 = *(const GAS u32x4*)(base + hf * 8), a1 = *(const GAS u32x4*)(base + 2048 + hf * 8), a2 = *(const GAS u32x4*)(base + 4096 + hf * 8);
                    u32x4 w;
#pragma unroll
                    for (int k = 0; k < 4; ++k) {
                        const float lo = w0 * bf_lo(a0[k]) + w1 * bf_lo(a1[k]) + w2 * bf_lo(a2[k]);
                        const float hi = w0 * bf_hi(a0[k]) + w1 * bf_hi(a1[k]) + w2 * bf_hi(a2[k]);
                        w[k] = cvt_pk_bf16(lo, hi);
                    }
                    *(GAS u32x4*)(base + hf * 8) = w;
                }
            }
            GRID_BAR();
            Ares = QKB; lda_res = 6144; Kres = 1024; Wres = DOW + (size_t)j * DM * 1024; sres = 1.0f;
        }
        { pg8::Gemm g{Ares, lda_res, Kres}; pg8::BPlain B{Wres, Kres}; pg8::StaticOrder S; S.init(MTOK, DM, G, bx); pg8::EpiResid E{out, DM, ALPHA, sres};
          pg8::gemm_phase<pg8::EpiResid, pg8::BPlain>(lds, g, B, S, E); }
        GRID_BAR();
        {
            const GAS f32x4* gp = (const GAS f32x4*)(args.in[2] + (size_t)sl * DM) + lane; const GAS f32x4* bp = (const GAS f32x4*)(args.in[3] + (size_t)sl * DM) + lane;
            for (int m = gw; m < MTOK; m += NGW) {
                GAS f32x4* yr = (GAS f32x4*)(out + (size_t)m * DM) + lane; GAS u32x2* brow = (GAS u32x2*)(XB + (size_t)m * DM) + lane;
                f32x4 v[8]; float s = 0.f;
#pragma unroll
                for (int jj = 0; jj < 8; ++jj) { v[jj] = yr[64 * jj]; s += (v[jj][0] + v[jj][1]) + (v[jj][2] + v[jj][3]); }
                const float mean = wave_sum(s) * (1.f / DM); float s2 = 0.f;
#pragma unroll
                for (int jj = 0; jj < 8; ++jj) { v[jj] = v[jj] - mean; s2 += (v[jj][0] * v[jj][0] + v[jj][1] * v[jj][1]) + (v[jj][2] * v[jj][2] + v[jj][3] * v[jj][3]); }
                const float rstd = 1.f / sqrtf(wave_sum(s2) * (1.f / DM) + LN_EPS);
#pragma unroll
                for (int jj = 0; jj < 8; ++jj) { const f32x4 o = v[jj] * rstd * gp[64 * jj] + bp[64 * jj]; yr[64 * jj] = o;
                    u32x2 w; w.x = cvt_pk_bf16(o[0], o[1]); w.y = cvt_pk_bf16(o[2], o[3]); brow[64 * jj] = w; }
            }
        }
        if (sl != 11) GRID_BAR();
    }
#undef GRID_BAR
}

extern "C" void kernel_launch(void* const* d_in, const int* in_sizes, int n_in, void* d_out, int out_size, void* d_ws, size_t ws_size, hipStream_t stream) {
    static int grid = 0;
    if (grid == 0) {
        if (n_in != 13 || out_size != MTOK * DM || ws_size < WS_END) { fprintf(stderr, "kernel_launch: unexpected shapes (n_in %d, out %d, ws %zu < %zu); nothing launched\n", n_in, out_size, ws_size, (size_t)WS_END); grid = -1; return; }
        int dev = 0, cus = 0, per_cu = 0;
        if (hipGetDevice(&dev) != hipSuccess || hipDeviceGetAttribute(&cus, hipDeviceAttributeMultiprocessorCount, dev) != hipSuccess) { grid = -1; return; }
        if (hipFuncSetAttribute((const void*)fwd, hipFuncAttributeMaxDynamicSharedMemorySize, LDS_BYTES) != hipSuccess) { fprintf(stderr, "kernel_launch: hipFuncSetAttribute failed\n"); grid = -1; return; }
        if (hipOccupancyMaxActiveBlocksPerMultiprocessor(&per_cu, (const void*)fwd, NWAVES * 64, LDS_BYTES) != hipSuccess || per_cu < 1)
            fprintf(stderr, "kernel_launch: note: occupancy query reports %d workgroups per CU\n", per_cu);
        (void)hipGetLastError();
        grid = cus;
    }
    if (grid < 0) return;
    if (hipMemsetAsync((char*)d_ws + WS_CTL, 0, CTL_ZERO_BYTES, stream) != hipSuccess) { fprintf(stderr, "kernel_launch: memset failed\n"); return; }
    Args a{};
    for (int i = 0; i < 13; ++i) a.in[i] = (const float*)d_in[i];
    a.out = (float*)d_out; a.ws = (unsigned char*)d_ws;
    hipLaunchKernelGGL(fwd, dim3(grid), dim3(NWAVES * 64), LDS_BYTES, stream, a);
    const hipError_t le = hipPeekAtLastError();
    if (le != hipSuccess) fprintf(stderr, "kernel_launch: launch failed: %s\n", hipGetErrorName(le));
}
```

```cpp
#include <hip/hip_runtime.h>
#include <cstdio>
#include <cstdint>

#define GAS __attribute__((address_space(1)))
#define LAS __attribute__((address_space(3)))
typedef unsigned short bf16_t;
typedef short bf16x8 __attribute__((ext_vector_type(8)));
typedef float f32x4 __attribute__((ext_vector_type(4)));
typedef unsigned u32x4 __attribute__((ext_vector_type(4)));
typedef unsigned u32x2 __attribute__((ext_vector_type(2)));

#ifndef PROBE_GU
#define PROBE_GU 1
#endif
#ifndef PROBE_QKV
#define PROBE_QKV 1
#endif
#ifndef PROBE_ATT
#define PROBE_ATT 1
#endif
#ifndef PROBE_LN
#define PROBE_LN 1
#endif
#ifndef PROBE_P0
#define PROBE_P0 1
#endif
constexpr int DM = 2048, DFF = 5632;
constexpr int MTOK = 32768, PROMPT_TOK = 16384;
constexpr float ALPHA = 1.6817928305074290f;
constexpr float LN_EPS = 1e-5f;
constexpr float LOG2E = 1.4426950408889634f;
constexpr float QK_SCALE2 = 0.08838834764831845f * 1.4426950408889634f;

__device__ __forceinline__ unsigned cvt_pk_bf16(float lo, float hi) { unsigned r; asm volatile("v_cvt_pk_bf16_f32 %0, %1, %2" : "=v"(r) : "v"(lo), "v"(hi)); return r; }
__device__ __forceinline__ float bf_lo(unsigned w) { return __builtin_bit_cast(float, w << 16); }
__device__ __forceinline__ float bf_hi(unsigned w) { return __builtin_bit_cast(float, w & 0xffff0000u); }
__device__ __forceinline__ int imin(int a, int b) { return a < b ? a : b; }
__device__ __forceinline__ int imax(int a, int b) { return a > b ? a : b; }

namespace pg8 {
constexpr int BM = 256, BK = 64, HALF = 128, HTB = HALF * BK * 2  , STAGE_BYTES = 8 * HTB, NXCD = 8, WGM = 8;
__host__ __device__ __forceinline__ int lds_byte(int r, int c) { const int st = (r >> 4) * 2 + (c >> 5), rr = r & 15, cc = c & 31, ob = rr * 64 + cc * 2; return st * 1024 + (ob ^ (((ob >> 9) & 1) << 5)); }
__host__ __device__ __forceinline__ void stage_rc(int b, int& R, int& C) { const int st = b / 1024, sb = b % 1024, swz = sb ^ (((sb >> 9) & 1) << 5); R = (st >> 1) * 16 + swz / 64; C = (st & 1) * 32 + (swz % 64) / 2; }
__host__ __device__ __forceinline__ int perm32(int rho) { const int n = rho >> 4, i = rho & 15; return 8 * (i >> 2) + 4 * n + (i & 3); }

struct Unit { int pm, pn; };
struct Gemm { const bf16_t* A; int lda; int K; };

struct StaticOrder {
    int nM, nN, nwg, G, c;
    __device__ void init(int M, int N, int G_, int c_) { nM = M / BM; nN = N / BM; nwg = nM * nN; G = G_; c = c_; }
    __device__ bool next(int i, Unit& u) const {
        const long L = (long)i * G + c; if (L >= nwg) return false;
        int wgid = (int)L; { const int q = nwg / NXCD, r = nwg % NXCD, xcd = wgid % NXCD, off = wgid / NXCD; wgid = (xcd < r ? xcd * (q + 1) : r * (q + 1) + (xcd - r) * q) + off; }
        const int nig = WGM * nN, gid = wgid / nig, fm = gid * WGM, gsz = (nM - fm) < WGM ? (nM - fm) : WGM;
        u.pm = fm + ((wgid % nig) % gsz); u.pn = (wgid % nig) / gsz; return true;
    }
};
struct BPlain { const bf16_t* Bt; int ldb; static constexpr int RMUL = 1;
    __device__ __forceinline__ int ld() const { return ldb; }
    __device__ __forceinline__ const char* half(const Unit& u, int hh) const { return (const char*)Bt + (size_t)(u.pn * BM + hh * HALF) * (size_t)ldb * 2; } };
struct EpiBf16P {
    static constexpr bool PERM = true;
    bf16_t* O; int ldc;
    __device__ __forceinline__ void operator()(const f32x4 (&acc)[2][2][4][2], const Unit& u, int wr, int wc, int fr, int fq) const {
        const int row0 = u.pm * BM + wr * 64 + fr, col0 = u.pn * BM + wc * 32 + 8 * fq;
#pragma unroll
        for (int ai = 0; ai < 2; ++ai)
#pragma unroll
            for (int m = 0; m < 4; ++m) { bf16_t* rowp = O + (size_t)(row0 + ai * HALF + m * 16) * ldc + col0;
#pragma unroll
                for (int bj = 0; bj < 2; ++bj) { const f32x4 v0 = acc[ai][bj][m][0], v1 = acc[ai][bj][m][1];
                    u32x4 w; w.x = cvt_pk_bf16(v0[0], v0[1]); w.y = cvt_pk_bf16(v0[2], v0[3]); w.z = cvt_pk_bf16(v1[0], v1[1]); w.w = cvt_pk_bf16(v1[2], v1[3]);
                    *(u32x4*)(rowp + bj * HALF) = w; } }
    }
};
__device__ __forceinline__ float silu_mul(float g, float u) { return g * u * __builtin_amdgcn_rcpf(1.0f + __builtin_amdgcn_exp2f(-LOG2E * g)); }
struct EpiSwiGLU {
    static constexpr bool PERM = true;
    bf16_t* H; int ldc;
    __device__ __forceinline__ void operator()(const f32x4 (&acc)[2][2][4][2], const Unit& u, int wr, int wc, int fr, int fq) const {
        const int row0 = u.pm * BM + wr * 64 + fr, col0 = u.pn * HALF + wc * 32 + 8 * fq;
#pragma unroll
        for (int ai = 0; ai < 2; ++ai)
#pragma unroll
            for (int m = 0; m < 4; ++m) { bf16_t* rowp = H + (size_t)(row0 + ai * HALF + m * 16) * ldc + col0;
                const f32x4 g0 = acc[ai][0][m][0], g1 = acc[ai][0][m][1], u0 = acc[ai][1][m][0], u1 = acc[ai][1][m][1];
                u32x4 w; w.x = cvt_pk_bf16(silu_mul(g0[0], u0[0]), silu_mul(g0[1], u0[1])); w.y = cvt_pk_bf16(silu_mul(g0[2], u0[2]), silu_mul(g0[3], u0[3]));
                w.z = cvt_pk_bf16(silu_mul(g1[0], u1[0]), silu_mul(g1[1], u1[1])); w.w = cvt_pk_bf16(silu_mul(g1[2], u1[2]), silu_mul(g1[3], u1[3]));
                *(u32x4*)rowp = w; }
    }
};
struct EpiResid {
    static constexpr bool PERM = false;
    float* Y; int ldc; float alpha, s;
    __device__ __forceinline__ void operator()(const f32x4 (&acc)[2][2][4][2], const Unit& u, int wr, int wc, int fr, int fq) const {
        const int row0 = u.pm * BM + wr * 64 + fr, col0 = u.pn * BM + wc * 32 + 4 * fq;
#pragma unroll
        for (int ai = 0; ai < 2; ++ai)
#pragma unroll
            for (int m = 0; m < 4; ++m) { float* rowp = Y + (size_t)(row0 + ai * HALF + m * 16) * ldc + col0;
#pragma unroll
                for (int bj = 0; bj < 2; ++bj)
#pragma unroll
                    for (int n = 0; n < 2; ++n) { float* p = rowp + bj * HALF + n * 16; const f32x4 x = *(const f32x4*)p; *(f32x4*)p = x * alpha + acc[ai][bj][m][n] * s; }
                asm volatile("" ::: "memory"); }
    }
};

template <class Epi, class BS>
__device__ __forceinline__ void gemm_phase(LAS unsigned char* lds, const Gemm g, const BS B, const StaticOrder& S, const Epi& E, int tid_in) {
    int tid = tid_in; asm volatile("" : "+v"(tid));
    const int wid = __builtin_amdgcn_readfirstlane(tid >> 6), lane = tid & 63, wr = wid >> 2, wc = wid & 3, fr = lane & 15, fq = lane >> 4;
    const int K = g.K, nt = K / BK, lda = g.lda, ldb = B.ld();
    unsigned voffA[2], voffB[2];
#pragma unroll
    for (int i = 0; i < 2; ++i) { int R, C; stage_rc(tid * 16 + i * 8192, R, C); const int Rb = Epi::PERM ? ((R & ~31) + perm32(R & 31)) : R;
        voffA[i] = (unsigned)(R * lda + C) * 2u; voffB[i] = (unsigned)(Rb * BS::RMUL * ldb + C) * 2u; }
    const size_t kstep = (size_t)(BK * 2);
    const size_t hstepA = (size_t)HALF * lda * 2;
    const size_t tstepA = 2 * hstepA;
    const unsigned ldsw = (unsigned)wid * 1024u;
    const int aoff = lds_byte(wr * 64 + fr, fq * 8), boff = lds_byte(wc * 32 + fr, fq * 8);
#define PG8_SA(b, h) (((b) * 2 + (h)) * HTB)
#define PG8_SB(b, h) ((4 + (b) * 2 + (h)) * HTB)
#define PG8_STAGE(bufoff, gbase, voff) do { _Pragma("unroll") for (int _i = 0; _i < 2; ++_i) \
        __builtin_amdgcn_global_load_lds((const unsigned*)((const char*)(gbase) + (voff)[_i]), (LAS unsigned*)(lds + (bufoff) + ldsw + _i * 8192), 16, 0, 0); } while (0)
#define PG8_LDA(dst, b, h) do { _Pragma("unroll") for (int m = 0; m < 4; ++m) _Pragma("unroll") for (int k = 0; k < 2; ++k) dst[m][k] = *(const LAS bf16x8*)(lds + PG8_SA(b, h) + aoff + m * 2048 + k * 1024); } while (0)
#define PG8_LDB(dst, b, h) do { _Pragma("unroll") for (int n = 0; n < 2; ++n) _Pragma("unroll") for (int k = 0; k < 2; ++k) dst[n][k] = *(const LAS bf16x8*)(lds + PG8_SB(b, h) + boff + n * 2048 + k * 1024); } while (0)
#define PG8_MMA(ai, bj, At, Bt) do { __builtin_amdgcn_s_setprio(1); _Pragma("unroll") for (int m = 0; m < 4; ++m) _Pragma("unroll") for (int n = 0; n < 2; ++n) _Pragma("unroll") for (int k = 0; k < 2; ++k) \
        acc[ai][bj][m][n] = __builtin_amdgcn_mfma_f32_16x16x32_bf16(Bt[n][k], At[m][k], acc[ai][bj][m][n], 0, 0, 0); __builtin_amdgcn_s_setprio(0); } while (0)
#define PG8_WAIT_V(n) asm volatile("s_waitcnt vmcnt(" #n ")" ::: "memory")
#define PG8_WAIT_L(n) asm volatile("s_waitcnt lgkmcnt(" #n ")" ::: "memory")
#define PG8_BAR __builtin_amdgcn_s_barrier()
#define PG8_SCHED __builtin_amdgcn_sched_barrier(0)
    Unit cur, nxt; int ui = 0;
    if (!S.next(0, cur)) return;
    f32x4 acc[2][2][4][2];
#pragma unroll
    for (int a = 0; a < 2; ++a)
#pragma unroll
        for (int b = 0; b < 2; ++b)
#pragma unroll
            for (int m = 0; m < 4; ++m)
#pragma unroll
                for (int n = 0; n < 2; ++n) acc[a][b][m][n] = (f32x4){0.f, 0.f, 0.f, 0.f};
    bf16x8 At[4][2], B0[2][2], B1[2][2];
    const char* cA = (const char*)g.A + (size_t)cur.pm * tstepA; const char* cB0 = B.half(cur, 0); const char* cB1 = B.half(cur, 1);
    PG8_STAGE(PG8_SB(0, 0), cB0, voffB); PG8_STAGE(PG8_SB(0, 1), cB1, voffB); PG8_STAGE(PG8_SA(0, 0), cA, voffA); PG8_STAGE(PG8_SA(0, 1), cA + hstepA, voffA);
    if (wr == 1) PG8_BAR;
    PG8_WAIT_V(2); PG8_BAR;
    PG8_STAGE(PG8_SB(1, 0), cB0 + kstep, voffB); PG8_STAGE(PG8_SA(1, 0), cA + kstep, voffA); PG8_STAGE(PG8_SB(1, 1), cB1 + kstep, voffB);
    PG8_WAIT_V(6); PG8_BAR;
    for (;;) {
        const bool has_next = S.next(ui + 1, nxt);
        const char* nA = has_next ? (const char*)g.A + (size_t)nxt.pm * tstepA : cA;
        const char* nB0 = has_next ? B.half(nxt, 0) : cB0; const char* nB1 = has_next ? B.half(nxt, 1) : cB1;
        for (int t = 0; t < nt; t += 2) {
            const bool last = (t == nt - 2);
            const char* a1 = cA + (size_t)(t + 1) * kstep;
            const char* a2 = last ? nA : cA + (size_t)(t + 2) * kstep;
            const char* b20 = last ? nB0 : cB0 + (size_t)(t + 2) * kstep; const char* b21 = last ? nB1 : cB1 + (size_t)(t + 2) * kstep;
            const char* a3 = a2 + kstep; const char* b30 = b20 + kstep; const char* b31 = b21 + kstep;
            PG8_LDB(B0, 0, 0); PG8_LDB(B1, 0, 1); PG8_SCHED; PG8_LDA(At, 0, 0); PG8_STAGE(PG8_SA(1, 1), a1 + hstepA, voffA);
            PG8_WAIT_V(8); PG8_WAIT_L(0); PG8_BAR; PG8_MMA(0, 0, At, B0); PG8_MMA(0, 1, At, B1); PG8_BAR; PG8_SCHED;
            PG8_LDA(At, 0, 1); PG8_STAGE(PG8_SB(0, 0), b20, voffB); PG8_STAGE(PG8_SB(0, 1), b21, voffB); PG8_STAGE(PG8_SA(0, 0), a2, voffA);
            PG8_WAIT_V(8); PG8_WAIT_L(0); PG8_BAR; PG8_MMA(1, 0, At, B0); PG8_MMA(1, 1, At, B1); PG8_BAR; PG8_SCHED;
            PG8_LDB(B0, 1, 0); PG8_LDB(B1, 1, 1); PG8_SCHED; PG8_LDA(At, 1, 0); PG8_STAGE(PG8_SA(0, 1), a2 + hstepA, voffA);
            PG8_WAIT_V(8); PG8_WAIT_L(0); PG8_BAR; PG8_MMA(0, 0, At, B0); PG8_MMA(0, 1, At, B1); PG8_BAR; PG8_SCHED;
            PG8_LDA(At, 1, 1); PG8_STAGE(PG8_SB(1, 0), b30, voffB); PG8_STAGE(PG8_SB(1, 1), b31, voffB); PG8_STAGE(PG8_SA(1, 0), a3, voffA);
            PG8_WAIT_V(8); PG8_WAIT_L(0); PG8_BAR; PG8_MMA(1, 0, At, B0); PG8_MMA(1, 1, At, B1); PG8_BAR; PG8_SCHED;
        }
        if (wr == 0) PG8_BAR;
        E(acc, cur, wr, wc, fr, fq);
        if (!has_next) break;
#pragma unroll
        for (int a = 0; a < 2; ++a)
#pragma unroll
            for (int b = 0; b < 2; ++b)
#pragma unroll
                for (int m = 0; m < 4; ++m)
#pragma unroll
                    for (int n = 0; n < 2; ++n) acc[a][b][m][n] = (f32x4){0.f, 0.f, 0.f, 0.f};
        cur = nxt; cA = nA; cB0 = nB0; cB1 = nB1; ++ui;
        if (wr == 1) PG8_BAR;
    }
    PG8_WAIT_V(0);
    PG8_BAR;
#undef PG8_SA
#undef PG8_SB
#undef PG8_STAGE
#undef PG8_LDA
#undef PG8_LDB
#undef PG8_MMA
#undef PG8_WAIT_V
#undef PG8_WAIT_L
#undef PG8_BAR
#undef PG8_SCHED
}
}

constexpr size_t MiB = 1u << 20;
constexpr size_t WS_CTL = 0, CTL_ZERO_BYTES = 1 * MiB;
constexpr size_t SZ_WGU1 = (size_t)2 * DFF * DM * 2, SZ_WD1 = (size_t)DM * DFF * 2;
constexpr size_t SZ_NAQKV1 = (size_t)3 * DM * DM * 2, SZ_NAO1 = (size_t)DM * DM * 2;
constexpr size_t SZ_DQKV1 = (size_t)9216 * DM * 2, SZ_DO1 = (size_t)DM * 1024 * 2;
constexpr size_t WS_WGU = 2 * MiB;
constexpr size_t WS_WD = WS_WGU + 8 * SZ_WGU1;
constexpr size_t WS_NAQKV = WS_WD + 8 * SZ_WD1;
constexpr size_t WS_NAO = WS_NAQKV + 2 * SZ_NAQKV1;
constexpr size_t WS_DQKV = WS_NAO + 2 * SZ_NAO1;
constexpr size_t WS_DO = WS_DQKV + 2 * SZ_DQKV1;
constexpr size_t WS_XB = WS_DO + 2 * SZ_DO1;
constexpr size_t WS_BIG = WS_XB + (size_t)MTOK * DM * 2;
constexpr size_t SZ_BIG = (size_t)MTOK * 9216 * 2;
constexpr size_t WS_LSE = WS_BIG + SZ_BIG;
constexpr size_t WS_END = WS_LSE + (size_t)MTOK * 24 * 4;
static_assert((size_t)MTOK * DFF * 2 <= SZ_BIG, "big buffer");
constexpr int CW_BAR = 4096;

constexpr int RING_BYTES = 131072;
constexpr int CTLZ_OFF = 147456 + 2048;
constexpr int MISC_OFF = CTLZ_OFF + 320;
constexpr int LDS_BYTES = 150528;
constexpr int NWAVES = 8;

#define RLX_AGENT __ATOMIC_RELAXED, __HIP_MEMORY_SCOPE_AGENT
#define LDS_WAIT() asm volatile("s_waitcnt lgkmcnt(0)" ::: "memory")

#define XB_TMO      128
#define XB_XCNT(j)  (256  + 64 * (j))
#define XB_XSUB(j)  (1280 + 64 * (j))
#define XB_XGEN(j)  (2304 + 64 * (j))
#define XB_TOP      3328
#define XB_TOPGEN   3392
#define XCD_BAR_WORDS 3456
#define XB_SPIN_CAP (1u << 20)

__device__ __forceinline__ unsigned xb_ld(unsigned* p)              { return __hip_atomic_load(p, __ATOMIC_RELAXED, __HIP_MEMORY_SCOPE_AGENT); }
__device__ __forceinline__ unsigned xb_add(unsigned* p, unsigned v) { return __hip_atomic_fetch_add(p, v, __ATOMIC_RELAXED, __HIP_MEMORY_SCOPE_AGENT); }
__device__ __forceinline__ unsigned xb_xcc_id() { return (unsigned)__builtin_amdgcn_s_getreg((3 << 11) | 20) & 0xFu; }
#define XB_SPIN(cond, bar) do { unsigned _sp = 0; while (cond) { __builtin_amdgcn_s_sleep(1); \
    if ((++_sp & 255u) == 0u) { if (xb_ld(&(bar)[XB_TMO])) break; if (_sp > XB_SPIN_CAP) { atomicAdd(&(bar)[XB_TMO], 1u); break; } } } } while (0)

__device__ __forceinline__ void xcd_barrier_post(unsigned* bar) {
    const unsigned x = xb_xcc_id();
    if (threadIdx.x == 0) (void)xb_add(&bar[XB_XCNT(x)], 1u);
}
__device__ __forceinline__ void xcd_barrier_complete(unsigned* bar, unsigned x, unsigned& nloc, unsigned& nx) {
    const unsigned G = gridDim.x * gridDim.y * gridDim.z;
    unsigned sum, cnt, mine, sp = 0u;
    for (;;) {
        sum = 0u; cnt = 0u; mine = 0u;
#pragma unroll
        for (unsigned j = 0; j < 16; ++j) { const unsigned c = xb_ld(&bar[XB_XCNT(j)]); sum += c; cnt += (c > 0u) ? 1u : 0u; mine = (j == x) ? c : mine; }
        if (sum == G) break;
        __builtin_amdgcn_s_sleep(1);
        if ((++sp & 255u) == 0u) { if (xb_ld(&bar[XB_TMO])) break; if (sp > XB_SPIN_CAP) { atomicAdd(&bar[XB_TMO], 1u); break; } }
    }
    nloc = mine > 0u ? mine : 1u; nx = cnt > 0u ? cnt : 1u;
}
__device__ __forceinline__ void xcd_barrier(unsigned* bar, volatile LAS unsigned* st, bool leader) {
    asm volatile("s_waitcnt vmcnt(0)" ::: "memory");
    __syncthreads();
    if (leader) {
        const unsigned x = xb_xcc_id();
        __builtin_amdgcn_s_waitcnt(0);
        unsigned nloc = st[0], nx = st[1];
        if (nloc == 0u) { xcd_barrier_complete(bar, x, nloc, nx); st[0] = nloc; st[1] = nx; }
        const unsigned old = xb_add(&bar[XB_XSUB(x)], 1u);
        const unsigned gen = old / nloc;
        if (old + 1u == (gen + 1u) * nloc) {
            __builtin_amdgcn_fence(__ATOMIC_RELEASE, "agent");
            asm volatile("s_waitcnt vmcnt(0)" ::: "memory");
            const unsigned og = xb_add(&bar[XB_TOP], 1u);
            const unsigned tg = og / nx;
            if (og + 1u == (tg + 1u) * nx) xb_add(&bar[XB_TOPGEN], 1u);
            else XB_SPIN(xb_ld(&bar[XB_TOPGEN]) == tg, bar);
            __builtin_amdgcn_fence(__ATOMIC_ACQUIRE, "agent");
            xb_add(&bar[XB_XGEN(x)], 1u);
            asm volatile("s_waitcnt vmcnt(0)" ::: "memory");
        } else {
            XB_SPIN(xb_ld(&bar[XB_XGEN(x)]) == gen, bar);
            __builtin_amdgcn_fence(__ATOMIC_ACQUIRE, "agent");
            asm volatile("s_waitcnt vmcnt(0)" ::: "memory");
        }
    }
    __syncthreads();
}

__device__ __forceinline__ float wave_sum(float v) {
#pragma unroll
    for (int o = 1; o < 64; o <<= 1) v += __shfl_xor(v, o);
    return v;
}
__device__ __forceinline__ void transpose_item(const float* W, int K, int N, bf16_t* WT, int drow0, int k0, int n0, LAS float* scr, int lane) {
#pragma unroll 8
    for (int i = 0; i < 32; ++i) { const int kk = 2 * i + (lane >> 5); scr[kk * 33 + (lane & 31)] = W[(size_t)(k0 + kk) * N + n0 + (lane & 31)]; }
    LDS_WAIT(); asm volatile("" ::: "memory");
    const int c = lane & 7;
#pragma unroll
    for (int j = 0; j < 4; ++j) { const int n = (lane >> 3) + 8 * j; const LAS float* s = scr + (8 * c) * 33 + n;
        u32x4 o; o.x = cvt_pk_bf16(s[0 * 33], s[1 * 33]); o.y = cvt_pk_bf16(s[2 * 33], s[3 * 33]); o.z = cvt_pk_bf16(s[4 * 33], s[5 * 33]); o.w = cvt_pk_bf16(s[6 * 33], s[7 * 33]);
        *(GAS u32x4*)(WT + (size_t)(drow0 + n) * K + k0 + 8 * c) = o; }
    LDS_WAIT(); asm volatile("" ::: "memory");
}

struct Args { const float* in[13]; float* out; unsigned char* ws; };

__device__ const unsigned char T5_BUCKET[3][65] = {
 {0, 1, 2, 3, 4, 5, 6, 7, 8, 8, 8, 8, 8, 8, 8, 9, 9, 9, 9, 9, 9, 9, 9, 9, 9, 9, 9, 10, 10, 10, 10, 10, 10, 10, 10, 10, 10, 10, 10, 10, 10, 10, 10, 10, 10, 10, 10, 10, 10, 10, 11, 11, 11, 11, 11, 11, 11, 11, 11, 11, 11, 11, 11, 11, 11},
 {0, 4, 8, 8, 9, 9, 9, 10, 10, 10, 10, 10, 10, 11, 11, 11, 11, 11, 11, 11, 11, 11, 11, 12, 12, 12, 12, 12, 12, 12, 12, 12, 12, 12, 12, 12, 12, 12, 12, 12, 12, 12, 13, 13, 13, 13, 13, 13, 13, 13, 13, 13, 13, 13, 13, 13, 13, 13, 13, 13, 13, 13, 13, 13, 13},
 {0, 9, 10, 10, 11, 11, 12, 12, 12, 12, 12, 13, 13, 13, 13, 13, 13, 13, 13, 13, 14, 14, 14, 14, 14, 14, 14, 14, 14, 14, 14, 14, 14, 14, 14, 15, 15, 15, 15, 15, 15, 15, 15, 15, 15, 15, 15, 15, 15, 15, 15, 15, 15, 15, 15, 15, 15, 15, 15, 15, 15, 15, 15, 15, 15}};

__device__ __forceinline__ bf16x8 pack8(const f32x4 a, const f32x4 b) {
    u32x4 w; w.x = cvt_pk_bf16(a[0], a[1]); w.y = cvt_pk_bf16(a[2], a[3]); w.z = cvt_pk_bf16(b[0], b[1]); w.w = cvt_pk_bf16(b[2], b[3]);
    return __builtin_bit_cast(bf16x8, w);
}
__device__ __forceinline__ bf16x8 join8(const u32x2 a, const u32x2 b) { u32x4 w; w.x = a.x; w.y = a.y; w.z = b.x; w.w = b.y; return __builtin_bit_cast(bf16x8, w); }

typedef short v4i16_t __attribute__((ext_vector_type(4)));
__device__ __forceinline__ u32x2 tr_read(const LAS unsigned char* p) { return __builtin_bit_cast(u32x2, __builtin_amdgcn_ds_read_tr16_b64_v4i16((LAS v4i16_t*)p)); }
__device__ __forceinline__ int swz_f(int r) { return ((r & 3) << 2) | ((r >> 2) & 3); }

__device__ __forceinline__ void na_unit(LAS unsigned char* lds, const GAS bf16_t* QKV, GAS bf16_t* O, int ldo, const float* rpb_h, int tok0, int rows, int r0, int h, int tid, int lane, int wave) {
    LAS float* rp = (LAS float*)(lds + 147456);
    const int q = lane & 15, g = lane >> 4, qj = wave & 3, r = r0 + (wave >> 2);
    const int rsu = imin(imax(r0 - 4, 0), rows - 8), rs = imin(imax(r - 4, 0), rows - 8);
    const int kb_lo = qj == 0 ? 0 : qj - 1;
    const bool three = (qj == 1) || (qj == 2);
    const int tq = tok0 + r * 64 + 16 * qj + q;
    const int wbase = ((rs - rsu) * 64 + 16 * kb_lo) * 256;
    __syncthreads();
    if (tid < 465) rp[tid] = rpb_h[tid] * LOG2E;
    const int srow = lane >> 4, spos = (lane & 15) ^ (srow << 2);
#pragma unroll 2
    for (int i = 0; i < 18; ++i) {
        const int trow = 72 * wave + 4 * i, kr = trow >> 6, col = (trow & 63) + srow;
        const int tok = tok0 + imin(rsu + kr, rows - 1) * 64 + col;
        __builtin_amdgcn_global_load_lds((const unsigned*)(QKV + (size_t)tok * 6144 + 2048 + h * 128 + 8 * (spos ^ ((trow >> 2) & 3))), (LAS unsigned*)(lds + trow * 256), 16, 0, 0);
    }
    bf16x8 qf[4];
#pragma unroll
    for (int kk = 0; kk < 4; ++kk) qf[kk] = *(const GAS bf16x8*)(QKV + (size_t)tq * 6144 + h * 128 + 32 * kk + 8 * g);
    asm volatile("s_waitcnt vmcnt(0)" ::: "memory");
    __syncthreads();
    const int fk = swz_f(q);
    const LAS unsigned char* klane = lds + wbase + q * 256;
    f32x4 s[8][3];
#pragma unroll
    for (int a = 0; a < 8; ++a)
#pragma unroll
        for (int kbi = 0; kbi < 3; ++kbi) {
            f32x4 acc = (f32x4){0.f, 0.f, 0.f, 0.f};
            if (kbi < 2 || three) {
                const LAS unsigned char* kp = klane + (a * 64 + 16 * kbi) * 256;
#pragma unroll
                for (int kk = 0; kk < 4; ++kk) acc = __builtin_amdgcn_mfma_f32_16x16x32_bf16(*(const LAS bf16x8*)(kp + 16 * ((4 * kk + g) ^ fk)), qf[kk], acc, 0, 0, 0);
            }
            s[a][kbi] = acc;
        }
    const int cq = 16 * qj + q, cs = imin(imax(cq - 8, 0), 48);
    float mx = -1e30f;
#pragma unroll
    for (int a = 0; a < 8; ++a) {
        const LAS float* rpa = rp + (rs + a - r + 7) * 31;
#pragma unroll
        for (int kbi = 0; kbi < 3; ++kbi)
#pragma unroll
            for (int e = 0; e < 4; ++e) {
                const int ck = 16 * (kb_lo + kbi) + 4 * g + e;
                const bool valid = (kbi < 2 || three) && (ck >= cs) && (ck < cs + 16);
                const int dc = imin(imax(ck - cq + 15, 0), 30);
                const float v = valid ? s[a][kbi][e] * QK_SCALE2 + rpa[dc] : -1e30f;
                s[a][kbi][e] = v; mx = fmaxf(mx, v);
            }
    }
    mx = fmaxf(mx, __shfl_xor(mx, 16)); mx = fmaxf(mx, __shfl_xor(mx, 32));
    float sum = 0.f;
#pragma unroll
    for (int a = 0; a < 8; ++a)
#pragma unroll
        for (int kbi = 0; kbi < 3; ++kbi)
#pragma unroll
            for (int e = 0; e < 4; ++e) { const float p = __builtin_amdgcn_exp2f(s[a][kbi][e] - mx); s[a][kbi][e] = p; sum += p; }
    sum += __shfl_xor(sum, 16); sum += __shfl_xor(sum, 32);
    const float inv = 1.0f / sum;
    __syncthreads();
#pragma unroll 2
    for (int i = 0; i < 18; ++i) {
        const int trow = 72 * wave + 4 * i, kr = trow >> 6, col = (trow & 63) + srow;
        const int tok = tok0 + imin(rsu + kr, rows - 1) * 64 + col;
        __builtin_amdgcn_global_load_lds((const unsigned*)(QKV + (size_t)tok * 6144 + 4096 + h * 128 + 8 * (spos ^ ((trow >> 2) & 3))), (LAS unsigned*)(lds + trow * 256), 16, 0, 0);
    }
    asm volatile("s_waitcnt vmcnt(0)" ::: "memory");
    __syncthreads();
    f32x4 o[8];
#pragma unroll
    for (int dt = 0; dt < 8; ++dt) o[dt] = (f32x4){0.f, 0.f, 0.f, 0.f};
    const int qq = q >> 2, pp = lane & 3, fv = (qq << 2) | g;
    const LAS unsigned char* vlane = lds + wbase + (4 * g + qq) * 256 + 8 * (pp & 1);
    const f32x4 zero4 = (f32x4){0.f, 0.f, 0.f, 0.f};
#pragma unroll
    for (int a = 0; a < 8; ++a) {
        const LAS unsigned char* vx = vlane + (a * 64) * 256;
        const bf16x8 pf = pack8(s[a][0], s[a][1]);
#pragma unroll
        for (int dt = 0; dt < 8; ++dt) { const int co = 16 * ((2 * dt + (pp >> 1)) ^ fv);
            o[dt] = __builtin_amdgcn_mfma_f32_16x16x32_bf16(join8(tr_read(vx + co), tr_read(vx + 16 * 256 + co)), pf, o[dt], 0, 0, 0); }
        if (three) {
            const bf16x8 pf2 = pack8(s[a][2], zero4);
#pragma unroll
            for (int dt = 0; dt < 8; ++dt) { const int co = 16 * ((2 * dt + (pp >> 1)) ^ fv); const u32x2 x = tr_read(vx + 32 * 256 + co);
                o[dt] = __builtin_amdgcn_mfma_f32_16x16x32_bf16(join8(x, x), pf2, o[dt], 0, 0, 0); }
        }
    }
    GAS bf16_t* orow = O + (size_t)tq * ldo + h * 128;
#pragma unroll
    for (int dt = 0; dt < 8; ++dt) { const f32x4 v = o[dt] * inv; u32x2 w; w.x = cvt_pk_bf16(v[0], v[1]); w.y = cvt_pk_bf16(v[2], v[3]);
        *(GAS u32x2*)(orow + 16 * dt + 4 * g) = w; }
}

__device__ __forceinline__ void dil_unit(LAS unsigned char* lds, const GAS bf16_t* QKV, GAS bf16_t* O, int ldo, int colo, GAS float* LSE, const float* relb, int btok0, int grp, int sh, int L, int rho, int l0b, int h, int tid, int lane, int wave) {
    LAS float* bt = (LAS float*)(lds + 147456);
    const int q = lane & 15, g = lane >> 4;
    const int colq = grp * 3072 + h * 128;
    const int l0 = l0b + 16 * wave;
    const int tq = btok0 + ((l0 + q) << sh) + rho;
    __syncthreads();
    if (tid < 129) { const int rel = tid - 64, mag = rel < 0 ? -rel : rel; const int bucket = (rel > 0 ? 16 : 0) + T5_BUCKET[grp][mag];
        bt[tid] = relb[bucket * 24 + grp * 8 + h] * LOG2E; }
    const int srow = lane >> 4, spos = lane & 15;
#pragma unroll
    for (int i = 0; i < 8; ++i) {
        const int trow = 32 * wave + 4 * i + srow;
        const int lk = imin(imax(l0b - 64 + trow, 0), L - 1);
        const GAS bf16_t* src = QKV + (size_t)(btok0 + (lk << sh) + rho) * 9216 + colq + 8 * (spos ^ swz_f(trow));
        __builtin_amdgcn_global_load_lds((const unsigned*)(src + 1024), (LAS unsigned*)(lds + (32 * wave + 4 * i) * 256), 16, 0, 0);
        __builtin_amdgcn_global_load_lds((const unsigned*)(src + 2048), (LAS unsigned*)(lds + 65536 + (32 * wave + 4 * i) * 256), 16, 0, 0);
    }
    bf16x8 qf[4];
#pragma unroll
    for (int kk = 0; kk < 4; ++kk) qf[kk] = *(const GAS bf16x8*)(QKV + (size_t)tq * 9216 + colq + 32 * kk + 8 * g);
    asm volatile("s_waitcnt vmcnt(0)" ::: "memory");
    __syncthreads();
    const int fk = swz_f(q);
    f32x4 s[10];
#pragma unroll
    for (int kb = 0; kb < 9; ++kb) {
        const LAS unsigned char* kp = lds + (16 * wave + 16 * kb + q) * 256;
        f32x4 acc = (f32x4){0.f, 0.f, 0.f, 0.f};
#pragma unroll
        for (int kk = 0; kk < 4; ++kk) acc = __builtin_amdgcn_mfma_f32_16x16x32_bf16(*(const LAS bf16x8*)(kp + 16 * ((4 * kk + g) ^ fk)), qf[kk], acc, 0, 0, 0);
        s[kb] = acc;
    }
    s[9] = (f32x4){0.f, 0.f, 0.f, 0.f};
    float mx = -1e30f;
#pragma unroll
    for (int kb = 0; kb < 9; ++kb)
#pragma unroll
        for (int e = 0; e < 4; ++e) {
            const int rel = -64 + 16 * kb + 4 * g + e - q, lkey = l0 + q + rel;
            const bool valid = (rel >= -64) && (rel <= 64) && (lkey >= 0) && (lkey < L);
            const int bi = imin(imax(rel + 64, 0), 128);
            const float v = valid ? s[kb][e] * QK_SCALE2 + bt[bi] : -1e30f;
            s[kb][e] = v; mx = fmaxf(mx, v);
        }
    mx = fmaxf(mx, __shfl_xor(mx, 16)); mx = fmaxf(mx, __shfl_xor(mx, 32));
    float sum = 0.f;
#pragma unroll
    for (int kb = 0; kb < 9; ++kb)
#pragma unroll
        for (int e = 0; e < 4; ++e) { const float p = __builtin_amdgcn_exp2f(s[kb][e] - mx); s[kb][e] = p; sum += p; }
    sum += __shfl_xor(sum, 16); sum += __shfl_xor(sum, 32);
    const float inv = 1.0f / sum;
    if (g == 0) LSE[(size_t)tq * 24 + grp * 8 + h] = mx + __builtin_amdgcn_logf(sum);
    f32x4 o[8];
#pragma unroll
    for (int dt = 0; dt < 8; ++dt) o[dt] = (f32x4){0.f, 0.f, 0.f, 0.f};
    const int qq = q >> 2, pp = lane & 3, fv = (qq << 2) | g;
    const LAS unsigned char* vlane = lds + 65536 + (16 * wave + 4 * g + qq) * 256 + 8 * (pp & 1);
#pragma unroll
    for (int c = 0; c < 5; ++c) {
        const bf16x8 pf = pack8(s[2 * c], s[2 * c + 1]);
        const LAS unsigned char* vx = vlane + (32 * c) * 256;
        const int yo = (c == 4) ? 0 : 16 * 256;
#pragma unroll
        for (int dt = 0; dt < 8; ++dt) { const int co = 16 * ((2 * dt + (pp >> 1)) ^ fv);
            o[dt] = __builtin_amdgcn_mfma_f32_16x16x32_bf16(join8(tr_read(vx + co), tr_read(vx + yo + co)), pf, o[dt], 0, 0, 0); }
    }
    GAS bf16_t* orow = O + (size_t)tq * ldo + colo;
#pragma unroll
    for (int dt = 0; dt < 8; ++dt) { const f32x4 v = o[dt] * inv; u32x2 w; w.x = cvt_pk_bf16(v[0], v[1]); w.y = cvt_pk_bf16(v[2], v[3]);
        *(GAS u32x2*)(orow + 16 * dt + 4 * g) = w; }
}

__global__ void __launch_bounds__(NWAVES * 64, 2) fwd(Args args) {
    extern __shared__ __attribute__((aligned(16))) unsigned char lds_raw[];
    LAS unsigned char* lds = (LAS unsigned char*)lds_raw;
    volatile LAS unsigned* MISC = (volatile LAS unsigned*)(lds + MISC_OFF);
    const int G = gridDim.x, bx = blockIdx.x;
    const int vcu = (G % 8 == 0) ? (bx % 8) * (G / 8) + bx / 8 : bx;
    const int NGW = G * NWAVES;
    const int wave_k = __builtin_amdgcn_readfirstlane((int)threadIdx.x >> 6);
    { const int t0 = threadIdx.x; for (int u = t0; u < (LDS_BYTES - CTLZ_OFF) / 4; u += NWAVES * 64) ((LAS unsigned*)(lds + CTLZ_OFF))[u] = 0u; }
    __syncthreads();
    xcd_barrier_post((unsigned*)(args.ws + WS_CTL) + CW_BAR);
#define GRID_BAR() do { unsigned* b_ = (unsigned*)(args.ws + WS_CTL) + CW_BAR; asm volatile("" : "+s"(b_)); int w_ = wave_k; asm volatile("" : "+s"(w_)); \
    const bool ld_ = (w_ == 0) && (__builtin_amdgcn_mbcnt_hi(~0u, __builtin_amdgcn_mbcnt_lo(~0u, 0u)) == 0u); xcd_barrier(b_, MISC + 8, ld_); } while (0)
#define PHASE_LOCALS() int lane = (int)__builtin_amdgcn_mbcnt_hi(~0u, __builtin_amdgcn_mbcnt_lo(~0u, 0u)); asm volatile("" : "+v"(lane)); int wave = wave_k; asm volatile("" : "+s"(wave)); \
    const int tid = wave * 64 + lane; const int gw = vcu * NWAVES + wave; \
    unsigned char* ws = args.ws; asm volatile("" : "+s"(ws)); float* out = args.out; asm volatile("" : "+s"(out)); (void)tid; (void)gw; (void)out; \
    bf16_t* WGU = (bf16_t*)(ws + WS_WGU); bf16_t* WD = (bf16_t*)(ws + WS_WD); bf16_t* NAQKV = (bf16_t*)(ws + WS_NAQKV); bf16_t* NAO = (bf16_t*)(ws + WS_NAO); \
    bf16_t* DQKV = (bf16_t*)(ws + WS_DQKV); bf16_t* DOW = (bf16_t*)(ws + WS_DO); bf16_t* XB = (bf16_t*)(ws + WS_XB); bf16_t* BIG = (bf16_t*)(ws + WS_BIG); \
    float* LSE = (float*)(ws + WS_LSE); (void)WGU; (void)WD; (void)NAQKV; (void)NAO; (void)DQKV; (void)DOW; (void)XB; (void)BIG; (void)LSE;

    for (int rep = 0; rep < PROBE_P0; ++rep) {
        PHASE_LOCALS();
        LAS float* scr = (LAS float*)(lds + wave * 16384);
        constexpr int NFFN = 24 * 5632, NNAQ = 2 * 6144, NNAO = 2 * 2048, NDQ = 2 * 9216, NDO = 2 * 1024;
        constexpr int NITEMS = NFFN + NNAQ + NNAO + NDQ + NDO;
        for (int it = gw; it < NITEMS; it += NGW) {
            int r = it;
            if (r < NFFN) {
                const int m = r / 5632, rr = r - m * 5632, f = m / 3, kind = m - 3 * f;
                if (kind < 2) { const int kb = rr / 176, nb = rr - kb * 176, n0 = nb * 32;
                    transpose_item(args.in[4 + kind] + (size_t)f * DM * DFF, DM, DFF, WGU + (size_t)f * 2 * DFF * DM, (n0 >> 7) * 256 + (n0 & 127) + kind * 128, kb * 64, n0, scr, lane); }
                else { const int kb = rr / 64, nb = rr - kb * 64, n0 = nb * 32;
                    transpose_item(args.in[6] + (size_t)f * DFF * DM, DFF, DM, WD + (size_t)f * DM * DFF, n0, kb * 64, n0, scr, lane); }
                continue;
            }
            r -= NFFN;
            if (r < NNAQ) { const int j = r / 6144, rr = r - j * 6144, kb = rr / 192, nb = rr - kb * 192, n0 = nb * 32;
                transpose_item(args.in[7] + (size_t)j * DM * 6144, DM, 6144, NAQKV + (size_t)j * 6144 * DM, n0, kb * 64, n0, scr, lane); continue; }
            r -= NNAQ;
            if (r < NNAO) { const int j = r / 2048, rr = r - j * 2048, kb = rr / 64, nb = rr - kb * 64, n0 = nb * 32;
                transpose_item(args.in[8] + (size_t)j * DM * DM, DM, DM, NAO + (size_t)j * DM * DM, n0, kb * 64, n0, scr, lane); continue; }
            r -= NNAO;
            if (r < NDQ) { const int j = r / 9216, rr = r - j * 9216, kb = rr / 288, nb = rr - kb * 288, n0 = nb * 32;
                transpose_item(args.in[10] + (size_t)j * DM * 9216, DM, 9216, DQKV + (size_t)j * 9216 * DM, n0, kb * 64, n0, scr, lane); continue; }
            r -= NDQ;
            { const int j = r / 1024, rr = r - j * 1024, kb = rr / 64, nb = rr - kb * 64, n0 = nb * 32;
                transpose_item(args.in[11] + (size_t)j * 1024 * DM, 1024, DM, DOW + (size_t)j * DM * 1024, n0, kb * 64, n0, scr, lane); }
        }
        for (int m = gw; m < MTOK; m += NGW) {
            const float* src = m < PROMPT_TOK ? args.in[0] + (size_t)m * DM : args.in[1] + (size_t)(m - PROMPT_TOK) * DM;
            const GAS f32x4* xr = (const GAS f32x4*)src + lane; GAS f32x4* orow = (GAS f32x4*)(out + (size_t)m * DM) + lane; GAS u32x2* brow = (GAS u32x2*)(XB + (size_t)m * DM) + lane;
#pragma unroll
            for (int j = 0; j < 8; ++j) { const f32x4 v = xr[64 * j]; orow[64 * j] = v; u32x2 w; w.x = cvt_pk_bf16(v[0], v[1]); w.y = cvt_pk_bf16(v[2], v[3]); brow[64 * j] = w; }
        }
    }
    GRID_BAR();

    for (int sl = 0; sl < 12; ++sl) {
        const int li = sl / 3, kind = sl - 3 * li;
        PHASE_LOCALS();
        const bf16_t* Ares; int lda_res, Kres; const bf16_t* Wres; float sres;
        bf16_t* SCR = (bf16_t*)(ws + WS_END); (void)SCR;
        if (kind != 1) {
            const int f = li * 2 + (kind >> 1);
            for (int rep = 0; rep < PROBE_GU; ++rep) {
            { pg8::Gemm g{XB, DM, DM}; pg8::BPlain B{WGU + (size_t)f * 2 * DFF * DM, DM}; pg8::StaticOrder S; S.init(MTOK, 2 * DFF, G, bx); pg8::EpiSwiGLU E{BIG, DFF};
              pg8::gemm_phase<pg8::EpiSwiGLU, pg8::BPlain>(lds, g, B, S, E, tid); }
            GRID_BAR();
            }
            Ares = BIG; lda_res = DFF; Kres = DFF; Wres = WD + (size_t)f * DM * DFF; sres = 0.5f;
        } else if ((li & 1) == 0) {
            const int j = li >> 1;
            bf16_t* QKVB = BIG;
            for (int rep = 0; rep < PROBE_QKV; ++rep) {
            { pg8::Gemm g{XB, DM, DM}; pg8::BPlain B{NAQKV + (size_t)j * 6144 * DM, DM}; pg8::StaticOrder S; S.init(MTOK, 6144, G, bx); pg8::EpiBf16P E{QKVB, 6144};
              pg8::gemm_phase<pg8::EpiBf16P, pg8::BPlain>(lds, g, B, S, E, tid); }
            GRID_BAR();
            }
            for (int rep = PROBE_ATT - 1; rep >= 0; --rep) {
                const float* rpb = args.in[9] + (size_t)j * 16 * 465;
                GAS bf16_t* O = rep ? (GAS bf16_t*)SCR : (GAS bf16_t*)QKVB; const int ldo = rep ? 2048 : 6144;
                for (int id = vcu; id < 4096; id += G) {
                    int tok0, rows, h, pair;
                    if (id < 2048) { const int img = id >> 8, rem = id & 255; h = rem >> 4; pair = rem & 15; rows = 32; tok0 = img * 2048; }
                    else { const int i2 = id - 2048, img = i2 >> 9, rem = i2 & 511; h = rem >> 5; pair = rem & 31; rows = 64; tok0 = PROMPT_TOK + img * 4096; }
                    na_unit(lds, (const GAS bf16_t*)QKVB, O, ldo, rpb + h * 465, tok0, rows, 2 * pair, h, tid, lane, wave);
                }
                GRID_BAR();
            }
            Ares = QKVB; lda_res = 6144; Kres = DM; Wres = NAO + (size_t)j * DM * DM; sres = 1.0f;
        } else {
            const int j = li >> 1;
            bf16_t* QKVB = BIG;
            for (int rep = 0; rep < PROBE_QKV; ++rep) {
            { pg8::Gemm g{XB, DM, DM}; pg8::BPlain B{DQKV + (size_t)j * 9216 * DM, DM}; pg8::StaticOrder S; S.init(MTOK, 9216, G, bx); pg8::EpiBf16P E{QKVB, 9216};
              pg8::gemm_phase<pg8::EpiBf16P, pg8::BPlain>(lds, g, B, S, E, tid); }
            GRID_BAR();
            }
            for (int rep = PROBE_ATT - 1; rep >= 0; --rep) {
                GAS bf16_t* O = rep ? (GAS bf16_t*)SCR : (GAS bf16_t*)QKVB; const int ldo = rep ? 3072 : 9216, gstride = rep ? 1024 : 3072;
                for (int id = vcu; id < 6144; id += G) {
                    const int gh = id >> 8, pb = id & 255, grp = gh >> 3, h = gh & 7, sh = 2 * grp;
                    int T, btok0, pp;
                    if (pb < 128) { T = 2048; btok0 = (pb >> 4) * 2048; pp = (pb & 15) * 128; }
                    else { T = 4096; btok0 = PROMPT_TOK + ((pb - 128) >> 5) * 4096; pp = ((pb - 128) & 31) * 128; }
                    const int L = T >> sh, rho = pp / L, l0b = pp - rho * L;
                    dil_unit(lds, (const GAS bf16_t*)QKVB, O, ldo, grp * gstride + h * 128, (GAS float*)LSE, args.in[12], btok0, grp, sh, L, rho, l0b, h, tid, lane, wave);
                }
                GRID_BAR();
            }
            for (int rep = PROBE_ATT - 1; rep >= 0; --rep) {
            GAS bf16_t* MO = rep ? (GAS bf16_t*)SCR : (GAS bf16_t*)QKVB; const int ldm = rep ? 1024 : 9216;
            for (int tok = gw; tok < MTOK; tok += NGW) {
                const int h = lane >> 3, c16 = (lane & 7) * 16;
                const GAS float* lp = (const GAS float*)LSE + (size_t)tok * 24 + h;
                const float l0 = lp[0], l1 = lp[8], l2 = lp[16];
                const float m = fmaxf(l0, fmaxf(l1, l2));
                float w0 = __builtin_amdgcn_exp2f(l0 - m), w1 = __builtin_amdgcn_exp2f(l1 - m), w2 = __builtin_amdgcn_exp2f(l2 - m);
                const float inv = 1.0f / (w0 + w1 + w2); w0 *= inv; w1 *= inv; w2 *= inv;
                const GAS bf16_t* base = (const GAS bf16_t*)QKVB + (size_t)tok * 9216 + h * 128 + c16;
                GAS bf16_t* obase = MO + (size_t)tok * ldm + h * 128 + c16;
#pragma unroll
                for (int hf = 0; hf < 2; ++hf) {
                    const u32x4 a0 = *(const GAS u32x4*)(base + hf * 8), a1 = *(const GAS u32x4*)(base + 3072 + hf * 8), a2 = *(const GAS u32x4*)(base + 6144 + hf * 8);
                    u32x4 w;
#pragma unroll
                    for (int k = 0; k < 4; ++k) {
                        const float lo = w0 * bf_lo(a0[k]) + w1 * bf_lo(a1[k]) + w2 * bf_lo(a2[k]);
                        const float hi = w0 * bf_hi(a0[k]) + w1 * bf_hi(a1[k]) + w2 * bf_hi(a2[k]);
                        w[k] = cvt_pk_bf16(lo, hi);
                    }
                    *(GAS u32x4*)(obase + hf * 8) = w;
                }
            }
            GRID_BAR();
            }
            Ares = QKVB; lda_res = 9216; Kres = 1024; Wres = DOW + (size_t)j * DM * 1024; sres = 1.0f;
        }
        { pg8::Gemm g{Ares, lda_res, Kres}; pg8::BPlain B{Wres, Kres}; pg8::StaticOrder S; S.init(MTOK, DM, G, bx); pg8::EpiResid E{out, DM, ALPHA, sres};
          pg8::gemm_phase<pg8::EpiResid, pg8::BPlain>(lds, g, B, S, E, tid); }
        GRID_BAR();
        for (int rep = PROBE_LN - 1; rep >= 0; --rep) {
            const GAS f32x4* gp = (const GAS f32x4*)(args.in[2] + (size_t)sl * DM) + lane; const GAS f32x4* bp = (const GAS f32x4*)(args.in[3] + (size_t)sl * DM) + lane;
            float* xo = rep ? (float*)BIG : out; bf16_t* xbo = rep ? BIG + (size_t)MTOK * DM * 2 : XB;
            for (int m = gw; m < MTOK; m += NGW) {
                const GAS f32x4* yr = (const GAS f32x4*)(out + (size_t)m * DM) + lane; GAS f32x4* xr = (GAS f32x4*)(xo + (size_t)m * DM) + lane; GAS u32x2* brow = (GAS u32x2*)(xbo + (size_t)m * DM) + lane;
                f32x4 v[8]; float s = 0.f;
#pragma unroll
                for (int jj = 0; jj < 8; ++jj) { v[jj] = yr[64 * jj]; s += (v[jj][0] + v[jj][1]) + (v[jj][2] + v[jj][3]); }
                const float mean = wave_sum(s) * (1.f / DM); float s2 = 0.f;
#pragma unroll
                for (int jj = 0; jj < 8; ++jj) { v[jj] = v[jj] - mean; s2 += (v[jj][0] * v[jj][0] + v[jj][1] * v[jj][1]) + (v[jj][2] * v[jj][2] + v[jj][3] * v[jj][3]); }
                const float rstd = 1.f / sqrtf(wave_sum(s2) * (1.f / DM) + LN_EPS);
#pragma unroll
                for (int jj = 0; jj < 8; ++jj) { const f32x4 o = v[jj] * rstd * gp[64 * jj] + bp[64 * jj]; xr[64 * jj] = o;
                    u32x2 w; w.x = cvt_pk_bf16(o[0], o[1]); w.y = cvt_pk_bf16(o[2], o[3]); brow[64 * jj] = w; }
            }
            if (sl != 11 || rep) GRID_BAR();
        }
    }
#undef GRID_BAR
}

extern "C" void kernel_launch(void* const* d_in, const int* in_sizes, int n_in, void* d_out, int out_size, void* d_ws, size_t ws_size, hipStream_t stream) {
    static int grid = 0;
    if (grid == 0) {
        if (n_in != 13 || out_size != MTOK * DM || ws_size < WS_END + (size_t)((PROBE_ATT > 1) ? (size_t)MTOK * 3072 * 2 : 0)) { fprintf(stderr, "kernel_launch: unexpected shapes (n_in %d, out %d, ws %zu < %zu); nothing launched\n", n_in, out_size, ws_size, (size_t)WS_END); grid = -1; return; }
        int dev = 0, cus = 0, per_cu = 0;
        if (hipGetDevice(&dev) != hipSuccess || hipDeviceGetAttribute(&cus, hipDeviceAttributeMultiprocessorCount, dev) != hipSuccess) { grid = -1; return; }
        if (hipFuncSetAttribute((const void*)fwd, hipFuncAttributeMaxDynamicSharedMemorySize, LDS_BYTES) != hipSuccess) { fprintf(stderr, "kernel_launch: hipFuncSetAttribute failed\n"); grid = -1; return; }
        if (hipOccupancyMaxActiveBlocksPerMultiprocessor(&per_cu, (const void*)fwd, NWAVES * 64, LDS_BYTES) != hipSuccess || per_cu < 1)
            fprintf(stderr, "kernel_launch: note: occupancy query reports %d workgroups per CU\n", per_cu);
        (void)hipGetLastError();
        grid = cus;
    }
    if (grid < 0) return;
    if (hipMemsetAsync((char*)d_ws + WS_CTL, 0, CTL_ZERO_BYTES, stream) != hipSuccess) { fprintf(stderr, "kernel_launch: memset failed\n"); return; }
    Args a{};
    for (int i = 0; i < 13; ++i) a.in[i] = (const float*)d_in[i];
    a.out = (float*)d_out; a.ws = (unsigned char*)d_ws;
    hipLaunchKernelGGL(fwd, dim3(grid), dim3(NWAVES * 64), LDS_BYTES, stream, a);
    const hipError_t le = hipPeekAtLastError();
    if (le != hipSuccess) fprintf(stderr, "kernel_launch: launch failed: %s\n", hipGetErrorName(le));
}
```

```cpp
#include <hip/hip_runtime.h>
#include <cstdio>
#include <cstdint>

#define GAS __attribute__((address_space(1)))
#define LAS __attribute__((address_space(3)))
typedef unsigned short bf16_t;
typedef short bf16x8 __attribute__((ext_vector_type(8)));
typedef float f32x4 __attribute__((ext_vector_type(4)));
typedef unsigned u32x4 __attribute__((ext_vector_type(4)));
typedef unsigned u32x2 __attribute__((ext_vector_type(2)));

#ifndef PROBE_GU
#define PROBE_GU 1
#endif
#ifndef PROBE_QKV
#define PROBE_QKV 1
#endif
#ifndef PROBE_ATT
#define PROBE_ATT 1
#endif
#ifndef PROBE_LN
#define PROBE_LN 1
#endif
#ifndef PROBE_P0
#define PROBE_P0 1
#endif
constexpr int DM = 2048, DFF = 5632;
constexpr int MTOK = 32768, PROMPT_TOK = 16384;
constexpr float ALPHA = 1.6817928305074290f;
constexpr float LN_EPS = 1e-5f;
constexpr float LOG2E = 1.4426950408889634f;
constexpr float QK_SCALE2 = 0.08838834764831845f * 1.4426950408889634f;

__device__ __forceinline__ unsigned cvt_pk_bf16(float lo, float hi) { unsigned r; asm volatile("v_cvt_pk_bf16_f32 %0, %1, %2" : "=v"(r) : "v"(lo), "v"(hi)); return r; }
__device__ __forceinline__ float bf_lo(unsigned w) { return __builtin_bit_cast(float, w << 16); }
__device__ __forceinline__ float bf_hi(unsigned w) { return __builtin_bit_cast(float, w & 0xffff0000u); }
__device__ __forceinline__ int imin(int a, int b) { return a < b ? a : b; }
__device__ __forceinline__ int imax(int a, int b) { return a > b ? a : b; }

namespace pg8 {
constexpr int BM = 256, BK = 64, HALF = 128, HTB = HALF * BK * 2  , STAGE_BYTES = 8 * HTB, NXCD = 8, WGM = 8;
__host__ __device__ __forceinline__ int lds_byte(int r, int c) { const int st = (r >> 4) * 2 + (c >> 5), rr = r & 15, cc = c & 31, ob = rr * 64 + cc * 2; return st * 1024 + (ob ^ (((ob >> 9) & 1) << 5)); }
__host__ __device__ __forceinline__ void stage_rc(int b, int& R, int& C) { const int st = b / 1024, sb = b % 1024, swz = sb ^ (((sb >> 9) & 1) << 5); R = (st >> 1) * 16 + swz / 64; C = (st & 1) * 32 + (swz % 64) / 2; }
__host__ __device__ __forceinline__ int perm32(int rho) { const int n = rho >> 4, i = rho & 15; return 8 * (i >> 2) + 4 * n + (i & 3); }

struct Unit { int pm, pn; };
struct Gemm { const bf16_t* A; int lda; int K; };

struct StaticOrder {
    int nM, nN, nwg, G, c;
    __device__ void init(int M, int N, int G_, int c_) { nM = M / BM; nN = N / BM; nwg = nM * nN; G = G_; c = c_; }
    __device__ bool next(int i, Unit& u) const {
        const long L = (long)i * G + c; if (L >= nwg) return false;
        int wgid = (int)L; { const int q = nwg / NXCD, r = nwg % NXCD, xcd = wgid % NXCD, off = wgid / NXCD; wgid = (xcd < r ? xcd * (q + 1) : r * (q + 1) + (xcd - r) * q) + off; }
        const int nig = WGM * nN, gid = wgid / nig, fm = gid * WGM, gsz = (nM - fm) < WGM ? (nM - fm) : WGM;
        u.pm = fm + ((wgid % nig) % gsz); u.pn = (wgid % nig) / gsz; return true;
    }
};
struct BPlain { const bf16_t* Bt; int ldb; static constexpr int RMUL = 1;
    __device__ __forceinline__ int ld() const { return ldb; }
    __device__ __forceinline__ const char* half(const Unit& u, int hh) const { return (const char*)Bt + (size_t)(u.pn * BM + hh * HALF) * (size_t)ldb * 2; } };
struct LnFold { const float* stats; const float* c1; const float* c0;
    __device__ __forceinline__ void row(int r, float& mu, float& rstd) const {
        if (stats) { const float2 st = *(const float2*)(stats + 2 * (size_t)r); mu = st.x * (1.0f / DM); rstd = 1.0f / sqrtf(fmaxf(st.y * (1.0f / DM) - mu * mu, 0.f) + LN_EPS); } else { mu = 0.f; rstd = 1.f; } }
};
struct EpiBf16P {
    static constexpr bool PERM = true;
    bf16_t* O; int ldc; LnFold F;
    __device__ __forceinline__ void operator()(const f32x4 (&acc)[2][2][4][2], const Unit& u, int wr, int wc, int fr, int fq) const {
        const int row0 = u.pm * BM + wr * 64 + fr, col0 = u.pn * BM + wc * 32 + 8 * fq;
        f32x4 c1v[2][2], c0v[2][2];
#pragma unroll
        for (int bj = 0; bj < 2; ++bj)
#pragma unroll
            for (int n = 0; n < 2; ++n) { c1v[bj][n] = *(const f32x4*)(F.c1 + col0 + bj * HALF + 4 * n); c0v[bj][n] = *(const f32x4*)(F.c0 + col0 + bj * HALF + 4 * n); }
#pragma unroll
        for (int ai = 0; ai < 2; ++ai)
#pragma unroll
            for (int m = 0; m < 4; ++m) { const int row = row0 + ai * HALF + m * 16; bf16_t* rowp = O + (size_t)row * ldc + col0;
                float mu, rstd; F.row(row, mu, rstd);
#pragma unroll
                for (int bj = 0; bj < 2; ++bj) { const f32x4 v0 = (acc[ai][bj][m][0] - c1v[bj][0] * mu) * rstd + c0v[bj][0], v1 = (acc[ai][bj][m][1] - c1v[bj][1] * mu) * rstd + c0v[bj][1];
                    u32x4 w; w.x = cvt_pk_bf16(v0[0], v0[1]); w.y = cvt_pk_bf16(v0[2], v0[3]); w.z = cvt_pk_bf16(v1[0], v1[1]); w.w = cvt_pk_bf16(v1[2], v1[3]);
                    *(u32x4*)(rowp + bj * HALF) = w; } }
    }
};
__device__ __forceinline__ float silu_mul(float g, float u) { return g * u * __builtin_amdgcn_rcpf(1.0f + __builtin_amdgcn_exp2f(-LOG2E * g)); }
struct EpiSwiGLU {
    static constexpr bool PERM = true;
    bf16_t* H; int ldc; LnFold F;
    __device__ __forceinline__ void operator()(const f32x4 (&acc)[2][2][4][2], const Unit& u, int wr, int wc, int fr, int fq) const {
        const int row0 = u.pm * BM + wr * 64 + fr, col0 = u.pn * HALF + wc * 32 + 8 * fq, ccol0 = u.pn * BM + wc * 32 + 8 * fq;
        f32x4 c1v[2][2], c0v[2][2];
#pragma unroll
        for (int bj = 0; bj < 2; ++bj)
#pragma unroll
            for (int n = 0; n < 2; ++n) { c1v[bj][n] = *(const f32x4*)(F.c1 + ccol0 + bj * HALF + 4 * n); c0v[bj][n] = *(const f32x4*)(F.c0 + ccol0 + bj * HALF + 4 * n); }
#pragma unroll
        for (int ai = 0; ai < 2; ++ai)
#pragma unroll
            for (int m = 0; m < 4; ++m) { const int row = row0 + ai * HALF + m * 16; bf16_t* rowp = H + (size_t)row * ldc + col0;
                float mu, rstd; F.row(row, mu, rstd);
                const f32x4 g0 = (acc[ai][0][m][0] - c1v[0][0] * mu) * rstd + c0v[0][0], g1 = (acc[ai][0][m][1] - c1v[0][1] * mu) * rstd + c0v[0][1];
                const f32x4 u0 = (acc[ai][1][m][0] - c1v[1][0] * mu) * rstd + c0v[1][0], u1 = (acc[ai][1][m][1] - c1v[1][1] * mu) * rstd + c0v[1][1];
                u32x4 w; w.x = cvt_pk_bf16(silu_mul(g0[0], u0[0]), silu_mul(g0[1], u0[1])); w.y = cvt_pk_bf16(silu_mul(g0[2], u0[2]), silu_mul(g0[3], u0[3]));
                w.z = cvt_pk_bf16(silu_mul(g1[0], u1[0]), silu_mul(g1[1], u1[1])); w.w = cvt_pk_bf16(silu_mul(g1[2], u1[2]), silu_mul(g1[3], u1[3]));
                *(u32x4*)rowp = w; }
    }
};
struct EpiResidLn {
    static constexpr bool PERM = true;
    float* Y; bf16_t* YB; int ldc; float alpha, s; const float* stats_old; const float* g_old; const float* b_old; float* stats_new;
    __device__ __forceinline__ void operator()(const f32x4 (&acc)[2][2][4][2], const Unit& u, int wr, int wc, int fr, int fq) const {
        const int row0 = u.pm * BM + wr * 64 + fr, col0 = u.pn * BM + wc * 32 + 8 * fq;
        const LnFold Fin{stats_old, nullptr, nullptr};
        f32x4 gv[2][2], bv[2][2];
#pragma unroll
        for (int bj = 0; bj < 2; ++bj)
#pragma unroll
            for (int n = 0; n < 2; ++n) { if (stats_old) { gv[bj][n] = *(const f32x4*)(g_old + col0 + bj * HALF + 4 * n); bv[bj][n] = *(const f32x4*)(b_old + col0 + bj * HALF + 4 * n); }
                                          else { gv[bj][n] = (f32x4){1.f, 1.f, 1.f, 1.f}; bv[bj][n] = (f32x4){0.f, 0.f, 0.f, 0.f}; } }
#pragma unroll
        for (int ai = 0; ai < 2; ++ai)
#pragma unroll
            for (int m = 0; m < 4; ++m) { const int row = row0 + ai * HALF + m * 16; float* rowp = Y + (size_t)row * ldc + col0; bf16_t* browp = YB + (size_t)row * ldc + col0;
                float mu, rstd; Fin.row(row, mu, rstd);
                float ps = 0.f, pss = 0.f;
#pragma unroll
                for (int bj = 0; bj < 2; ++bj) { f32x4 yn[2];
#pragma unroll
                    for (int n = 0; n < 2; ++n) { float* p = rowp + bj * HALF + 4 * n; const f32x4 y = *(const f32x4*)p;
                        const f32x4 x = (y - mu) * rstd * gv[bj][n] + bv[bj][n]; yn[n] = x * alpha + acc[ai][bj][m][n] * s; *(f32x4*)p = yn[n];
                        ps += (yn[n][0] + yn[n][1]) + (yn[n][2] + yn[n][3]); pss += (yn[n][0] * yn[n][0] + yn[n][1] * yn[n][1]) + (yn[n][2] * yn[n][2] + yn[n][3] * yn[n][3]); }
                    u32x4 w; w.x = cvt_pk_bf16(yn[0][0], yn[0][1]); w.y = cvt_pk_bf16(yn[0][2], yn[0][3]); w.z = cvt_pk_bf16(yn[1][0], yn[1][1]); w.w = cvt_pk_bf16(yn[1][2], yn[1][3]);
                    *(u32x4*)(browp + bj * HALF) = w; }
                ps += __shfl_xor(ps, 16); ps += __shfl_xor(ps, 32); pss += __shfl_xor(pss, 16); pss += __shfl_xor(pss, 32);
                if (fq == 0) { __hip_atomic_fetch_add(stats_new + 2 * (size_t)row, ps, __ATOMIC_RELAXED, __HIP_MEMORY_SCOPE_AGENT); __hip_atomic_fetch_add(stats_new + 2 * (size_t)row + 1, pss, __ATOMIC_RELAXED, __HIP_MEMORY_SCOPE_AGENT); }
                asm volatile("" ::: "memory"); }
    }
};

template <class Epi, class BS>
__device__ __forceinline__ void gemm_phase(LAS unsigned char* lds, const Gemm g, const BS B, const StaticOrder& S, const Epi& E, int tid_in) {
    int tid = tid_in; asm volatile("" : "+v"(tid));
    const int wid = __builtin_amdgcn_readfirstlane(tid >> 6), lane = tid & 63, wr = wid >> 2, wc = wid & 3, fr = lane & 15, fq = lane >> 4;
    const int K = g.K, nt = K / BK, lda = g.lda, ldb = B.ld();
    unsigned voffA[2], voffB[2];
#pragma unroll
    for (int i = 0; i < 2; ++i) { int R, C; stage_rc(tid * 16 + i * 8192, R, C); const int Rb = Epi::PERM ? ((R & ~31) + perm32(R & 31)) : R;
        voffA[i] = (unsigned)(R * lda + C) * 2u; voffB[i] = (unsigned)(Rb * BS::RMUL * ldb + C) * 2u; }
    const size_t kstep = (size_t)(BK * 2);
    const size_t hstepA = (size_t)HALF * lda * 2;
    const size_t tstepA = 2 * hstepA;
    const unsigned ldsw = (unsigned)wid * 1024u;
    const int aoff = lds_byte(wr * 64 + fr, fq * 8), boff = lds_byte(wc * 32 + fr, fq * 8);
#define PG8_SA(b, h) (((b) * 2 + (h)) * HTB)
#define PG8_SB(b, h) ((4 + (b) * 2 + (h)) * HTB)
#define PG8_STAGE(bufoff, gbase, voff) do { _Pragma("unroll") for (int _i = 0; _i < 2; ++_i) \
        __builtin_amdgcn_global_load_lds((const unsigned*)((const char*)(gbase) + (voff)[_i]), (LAS unsigned*)(lds + (bufoff) + ldsw + _i * 8192), 16, 0, 0); } while (0)
#define PG8_LDA(dst, b, h) do { _Pragma("unroll") for (int m = 0; m < 4; ++m) _Pragma("unroll") for (int k = 0; k < 2; ++k) dst[m][k] = *(const LAS bf16x8*)(lds + PG8_SA(b, h) + aoff + m * 2048 + k * 1024); } while (0)
#define PG8_LDB(dst, b, h) do { _Pragma("unroll") for (int n = 0; n < 2; ++n) _Pragma("unroll") for (int k = 0; k < 2; ++k) dst[n][k] = *(const LAS bf16x8*)(lds + PG8_SB(b, h) + boff + n * 2048 + k * 1024); } while (0)
#define PG8_MMA(ai, bj, At, Bt) do { __builtin_amdgcn_s_setprio(1); _Pragma("unroll") for (int m = 0; m < 4; ++m) _Pragma("unroll") for (int n = 0; n < 2; ++n) _Pragma("unroll") for (int k = 0; k < 2; ++k) \
        acc[ai][bj][m][n] = __builtin_amdgcn_mfma_f32_16x16x32_bf16(Bt[n][k], At[m][k], acc[ai][bj][m][n], 0, 0, 0); __builtin_amdgcn_s_setprio(0); } while (0)
#define PG8_WAIT_V(n) asm volatile("s_waitcnt vmcnt(" #n ")" ::: "memory")
#define PG8_WAIT_L(n) asm volatile("s_waitcnt lgkmcnt(" #n ")" ::: "memory")
#define PG8_BAR __builtin_amdgcn_s_barrier()
#define PG8_SCHED __builtin_amdgcn_sched_barrier(0)
    Unit cur, nxt; int ui = 0;
    if (!S.next(0, cur)) return;
    f32x4 acc[2][2][4][2];
#pragma unroll
    for (int a = 0; a < 2; ++a)
#pragma unroll
        for (int b = 0; b < 2; ++b)
#pragma unroll
            for (int m = 0; m < 4; ++m)
#pragma unroll
                for (int n = 0; n < 2; ++n) acc[a][b][m][n] = (f32x4){0.f, 0.f, 0.f, 0.f};
    bf16x8 At[4][2], B0[2][2], B1[2][2];
    const char* cA = (const char*)g.A + (size_t)cur.pm * tstepA; const char* cB0 = B.half(cur, 0); const char* cB1 = B.half(cur, 1);
    PG8_STAGE(PG8_SB(0, 0), cB0, voffB); PG8_STAGE(PG8_SB(0, 1), cB1, voffB); PG8_STAGE(PG8_SA(0, 0), cA, voffA); PG8_STAGE(PG8_SA(0, 1), cA + hstepA, voffA);
    if (wr == 1) PG8_BAR;
    PG8_WAIT_V(2); PG8_BAR;
    PG8_STAGE(PG8_SB(1, 0), cB0 + kstep, voffB); PG8_STAGE(PG8_SA(1, 0), cA + kstep, voffA); PG8_STAGE(PG8_SB(1, 1), cB1 + kstep, voffB);
    PG8_WAIT_V(6); PG8_BAR;
    for (;;) {
        const bool has_next = S.next(ui + 1, nxt);
        const char* nA = has_next ? (const char*)g.A + (size_t)nxt.pm * tstepA : cA;
        const char* nB0 = has_next ? B.half(nxt, 0) : cB0; const char* nB1 = has_next ? B.half(nxt, 1) : cB1;
        for (int t = 0; t < nt; t += 2) {
            const bool last = (t == nt - 2);
            const char* a1 = cA + (size_t)(t + 1) * kstep;
            const char* a2 = last ? nA : cA + (size_t)(t + 2) * kstep;
            const char* b20 = last ? nB0 : cB0 + (size_t)(t + 2) * kstep; const char* b21 = last ? nB1 : cB1 + (size_t)(t + 2) * kstep;
            const char* a3 = a2 + kstep; const char* b30 = b20 + kstep; const char* b31 = b21 + kstep;
            PG8_LDB(B0, 0, 0); PG8_LDB(B1, 0, 1); PG8_SCHED; PG8_LDA(At, 0, 0); PG8_STAGE(PG8_SA(1, 1), a1 + hstepA, voffA);
            PG8_WAIT_V(8); PG8_WAIT_L(0); PG8_BAR; PG8_MMA(0, 0, At, B0); PG8_MMA(0, 1, At, B1); PG8_BAR; PG8_SCHED;
            PG8_LDA(At, 0, 1); PG8_STAGE(PG8_SB(0, 0), b20, voffB); PG8_STAGE(PG8_SB(0, 1), b21, voffB); PG8_STAGE(PG8_SA(0, 0), a2, voffA);
            PG8_WAIT_V(8); PG8_WAIT_L(0); PG8_BAR; PG8_MMA(1, 0, At, B0); PG8_MMA(1, 1, At, B1); PG8_BAR; PG8_SCHED;
            PG8_LDB(B0, 1, 0); PG8_LDB(B1, 1, 1); PG8_SCHED; PG8_LDA(At, 1, 0); PG8_STAGE(PG8_SA(0, 1), a2 + hstepA, voffA);
            PG8_WAIT_V(8); PG8_WAIT_L(0); PG8_BAR; PG8_MMA(0, 0, At, B0); PG8_MMA(0, 1, At, B1); PG8_BAR; PG8_SCHED;
            PG8_LDA(At, 1, 1); PG8_STAGE(PG8_SB(1, 0), b30, voffB); PG8_STAGE(PG8_SB(1, 1), b31, voffB); PG8_STAGE(PG8_SA(1, 0), a3, voffA);
            PG8_WAIT_V(8); PG8_WAIT_L(0); PG8_BAR; PG8_MMA(1, 0, At, B0); PG8_MMA(1, 1, At, B1); PG8_BAR; PG8_SCHED;
        }
        if (wr == 0) PG8_BAR;
        E(acc, cur, wr, wc, fr, fq);
        if (!has_next) break;
#pragma unroll
        for (int a = 0; a < 2; ++a)
#pragma unroll
            for (int b = 0; b < 2; ++b)
#pragma unroll
                for (int m = 0; m < 4; ++m)
#pragma unroll
                    for (int n = 0; n < 2; ++n) acc[a][b][m][n] = (f32x4){0.f, 0.f, 0.f, 0.f};
        cur = nxt; cA = nA; cB0 = nB0; cB1 = nB1; ++ui;
        if (wr == 1) PG8_BAR;
    }
    PG8_WAIT_V(0);
    PG8_BAR;
#undef PG8_SA
#undef PG8_SB
#undef PG8_STAGE
#undef PG8_LDA
#undef PG8_LDB
#undef PG8_MMA
#undef PG8_WAIT_V
#undef PG8_WAIT_L
#undef PG8_BAR
#undef PG8_SCHED
}
}

constexpr size_t MiB = 1u << 20;
constexpr size_t WS_CTL = 0, CTL_ZERO_BYTES = 6 * MiB;
constexpr size_t WS_STATS = 1 * MiB;
constexpr size_t WS_C1 = 4 * MiB + 512 * 1024, WS_C0 = 5 * MiB + 256 * 1024;
constexpr int CSTRIDE = 2 * DFF;
static_assert(WS_STATS + (size_t)12 * MTOK * 2 * 4 <= WS_C1 && WS_C1 + (size_t)12 * CSTRIDE * 4 <= WS_C0 && WS_C0 + (size_t)12 * CSTRIDE * 4 <= CTL_ZERO_BYTES, "zeroed region");
constexpr size_t SZ_WGU1 = (size_t)2 * DFF * DM * 2, SZ_WD1 = (size_t)DM * DFF * 2;
constexpr size_t SZ_NAQKV1 = (size_t)3 * DM * DM * 2, SZ_NAO1 = (size_t)DM * DM * 2;
constexpr size_t SZ_DQKV1 = (size_t)9216 * DM * 2, SZ_DO1 = (size_t)DM * 1024 * 2;
constexpr size_t WS_WGU = 6 * MiB;
constexpr size_t WS_WD = WS_WGU + 8 * SZ_WGU1;
constexpr size_t WS_NAQKV = WS_WD + 8 * SZ_WD1;
constexpr size_t WS_NAO = WS_NAQKV + 2 * SZ_NAQKV1;
constexpr size_t WS_DQKV = WS_NAO + 2 * SZ_NAO1;
constexpr size_t WS_DO = WS_DQKV + 2 * SZ_DQKV1;
constexpr size_t WS_XB = WS_DO + 2 * SZ_DO1;
constexpr size_t WS_BIG = WS_XB + (size_t)MTOK * DM * 2;
constexpr size_t SZ_BIG = (size_t)MTOK * 9216 * 2;
constexpr size_t WS_LSE = WS_BIG + SZ_BIG;
constexpr size_t WS_END = WS_LSE + (size_t)MTOK * 24 * 4;
static_assert((size_t)MTOK * DFF * 2 <= SZ_BIG, "big buffer");
constexpr int CW_BAR = 4096;

constexpr int RING_BYTES = 131072;
constexpr int CTLZ_OFF = 147456 + 2048;
constexpr int MISC_OFF = CTLZ_OFF + 320;
constexpr int LDS_BYTES = 150528;
constexpr int NWAVES = 8;

#define RLX_AGENT __ATOMIC_RELAXED, __HIP_MEMORY_SCOPE_AGENT
#define LDS_WAIT() asm volatile("s_waitcnt lgkmcnt(0)" ::: "memory")

#define XB_TMO      128
#define XB_XCNT(j)  (256  + 64 * (j))
#define XB_XSUB(j)  (1280 + 64 * (j))
#define XB_XGEN(j)  (2304 + 64 * (j))
#define XB_TOP      3328
#define XB_TOPGEN   3392
#define XCD_BAR_WORDS 3456
#define XB_SPIN_CAP (1u << 20)

__device__ __forceinline__ unsigned xb_ld(unsigned* p)              { return __hip_atomic_load(p, __ATOMIC_RELAXED, __HIP_MEMORY_SCOPE_AGENT); }
__device__ __forceinline__ unsigned xb_add(unsigned* p, unsigned v) { return __hip_atomic_fetch_add(p, v, __ATOMIC_RELAXED, __HIP_MEMORY_SCOPE_AGENT); }
__device__ __forceinline__ unsigned xb_xcc_id() { return (unsigned)__builtin_amdgcn_s_getreg((3 << 11) | 20) & 0xFu; }
#define XB_SPIN(cond, bar) do { unsigned _sp = 0; while (cond) { __builtin_amdgcn_s_sleep(1); \
    if ((++_sp & 255u) == 0u) { if (xb_ld(&(bar)[XB_TMO])) break; if (_sp > XB_SPIN_CAP) { atomicAdd(&(bar)[XB_TMO], 1u); break; } } } } while (0)

__device__ __forceinline__ void xcd_barrier_post(unsigned* bar) {
    const unsigned x = xb_xcc_id();
    if (threadIdx.x == 0) (void)xb_add(&bar[XB_XCNT(x)], 1u);
}
__device__ __forceinline__ void xcd_barrier_complete(unsigned* bar, unsigned x, unsigned& nloc, unsigned& nx) {
    const unsigned G = gridDim.x * gridDim.y * gridDim.z;
    unsigned sum, cnt, mine, sp = 0u;
    for (;;) {
        sum = 0u; cnt = 0u; mine = 0u;
#pragma unroll
        for (unsigned j = 0; j < 16; ++j) { const unsigned c = xb_ld(&bar[XB_XCNT(j)]); sum += c; cnt += (c > 0u) ? 1u : 0u; mine = (j == x) ? c : mine; }
        if (sum == G) break;
        __builtin_amdgcn_s_sleep(1);
        if ((++sp & 255u) == 0u) { if (xb_ld(&bar[XB_TMO])) break; if (sp > XB_SPIN_CAP) { atomicAdd(&bar[XB_TMO], 1u); break; } }
    }
    nloc = mine > 0u ? mine : 1u; nx = cnt > 0u ? cnt : 1u;
}
__device__ __forceinline__ void xcd_barrier(unsigned* bar, volatile LAS unsigned* st, bool leader) {
    asm volatile("s_waitcnt vmcnt(0)" ::: "memory");
    __syncthreads();
    if (leader) {
        const unsigned x = xb_xcc_id();
        __builtin_amdgcn_s_waitcnt(0);
        unsigned nloc = st[0], nx = st[1];
        if (nloc == 0u) { xcd_barrier_complete(bar, x, nloc, nx); st[0] = nloc; st[1] = nx; }
        const unsigned old = xb_add(&bar[XB_XSUB(x)], 1u);
        const unsigned gen = old / nloc;
        if (old + 1u == (gen + 1u) * nloc) {
            __builtin_amdgcn_fence(__ATOMIC_RELEASE, "agent");
            asm volatile("s_waitcnt vmcnt(0)" ::: "memory");
            const unsigned og = xb_add(&bar[XB_TOP], 1u);
            const unsigned tg = og / nx;
            if (og + 1u == (tg + 1u) * nx) xb_add(&bar[XB_TOPGEN], 1u);
            else XB_SPIN(xb_ld(&bar[XB_TOPGEN]) == tg, bar);
            __builtin_amdgcn_fence(__ATOMIC_ACQUIRE, "agent");
            xb_add(&bar[XB_XGEN(x)], 1u);
            asm volatile("s_waitcnt vmcnt(0)" ::: "memory");
        } else {
            XB_SPIN(xb_ld(&bar[XB_XGEN(x)]) == gen, bar);
            __builtin_amdgcn_fence(__ATOMIC_ACQUIRE, "agent");
            asm volatile("s_waitcnt vmcnt(0)" ::: "memory");
        }
    }
    __syncthreads();
}

__device__ __forceinline__ float wave_sum(float v) {
#pragma unroll
    for (int o = 1; o < 64; o <<= 1) v += __shfl_xor(v, o);
    return v;
}
__device__ __forceinline__ void transpose_item(const float* W, int K, int N, bf16_t* WT, int drow0, int k0, int n0, LAS float* scr, int lane, const float* gvec, const float* bvec, float* c1, float* c0) {
#pragma unroll 8
    for (int i = 0; i < 32; ++i) { const int kk = 2 * i + (lane >> 5); scr[kk * 33 + (lane & 31)] = W[(size_t)(k0 + kk) * N + n0 + (lane & 31)]; }
    LDS_WAIT(); asm volatile("" ::: "memory");
    const int c = lane & 7;
    float gk[8], bk[8];
#pragma unroll
    for (int i = 0; i < 8; ++i) { gk[i] = gvec ? gvec[k0 + 8 * c + i] : 1.f; bk[i] = gvec ? bvec[k0 + 8 * c + i] : 0.f; }
#pragma unroll
    for (int j = 0; j < 4; ++j) { const int n = (lane >> 3) + 8 * j; const LAS float* sp = scr + (8 * c) * 33 + n;
        float w[8]; float p0 = 0.f;
#pragma unroll
        for (int i = 0; i < 8; ++i) { const float x = sp[i * 33]; w[i] = x * gk[i]; p0 += x * bk[i]; }
        u32x4 o; o.x = cvt_pk_bf16(w[0], w[1]); o.y = cvt_pk_bf16(w[2], w[3]); o.z = cvt_pk_bf16(w[4], w[5]); o.w = cvt_pk_bf16(w[6], w[7]);
        *(GAS u32x4*)(WT + (size_t)(drow0 + n) * K + k0 + 8 * c) = o;
        if (gvec) {
            float p1 = ((bf_lo(o.x) + bf_hi(o.x)) + (bf_lo(o.y) + bf_hi(o.y))) + ((bf_lo(o.z) + bf_hi(o.z)) + (bf_lo(o.w) + bf_hi(o.w)));
#pragma unroll
            for (int m = 1; m < 8; m <<= 1) { p1 += __shfl_xor(p1, m); p0 += __shfl_xor(p0, m); }
            if (c == 0) { __hip_atomic_fetch_add(c1 + drow0 + n, p1, __ATOMIC_RELAXED, __HIP_MEMORY_SCOPE_AGENT); __hip_atomic_fetch_add(c0 + drow0 + n, p0, __ATOMIC_RELAXED, __HIP_MEMORY_SCOPE_AGENT); }
        }
    }
    LDS_WAIT(); asm volatile("" ::: "memory");
}

struct Args { const float* in[13]; float* out; unsigned char* ws; };

__device__ const unsigned char T5_BUCKET[3][65] = {
 {0, 1, 2, 3, 4, 5, 6, 7, 8, 8, 8, 8, 8, 8, 8, 9, 9, 9, 9, 9, 9, 9, 9, 9, 9, 9, 9, 10, 10, 10, 10, 10, 10, 10, 10, 10, 10, 10, 10, 10, 10, 10, 10, 10, 10, 10, 10, 10, 10, 10, 11, 11, 11, 11, 11, 11, 11, 11, 11, 11, 11, 11, 11, 11, 11},
 {0, 4, 8, 8, 9, 9, 9, 10, 10, 10, 10, 10, 10, 11, 11, 11, 11, 11, 11, 11, 11, 11, 11, 12, 12, 12, 12, 12, 12, 12, 12, 12, 12, 12, 12, 12, 12, 12, 12, 12, 12, 12, 13, 13, 13, 13, 13, 13, 13, 13, 13, 13, 13, 13, 13, 13, 13, 13, 13, 13, 13, 13, 13, 13, 13},
 {0, 9, 10, 10, 11, 11, 12, 12, 12, 12, 12, 13, 13, 13, 13, 13, 13, 13, 13, 13, 14, 14, 14, 14, 14, 14, 14, 14, 14, 14, 14, 14, 14, 14, 14, 15, 15, 15, 15, 15, 15, 15, 15, 15, 15, 15, 15, 15, 15, 15, 15, 15, 15, 15, 15, 15, 15, 15, 15, 15, 15, 15, 15, 15, 15}};

__device__ __forceinline__ bf16x8 pack8(const f32x4 a, const f32x4 b) {
    u32x4 w; w.x = cvt_pk_bf16(a[0], a[1]); w.y = cvt_pk_bf16(a[2], a[3]); w.z = cvt_pk_bf16(b[0], b[1]); w.w = cvt_pk_bf16(b[2], b[3]);
    return __builtin_bit_cast(bf16x8, w);
}
__device__ __forceinline__ bf16x8 join8(const u32x2 a, const u32x2 b) { u32x4 w; w.x = a.x; w.y = a.y; w.z = b.x; w.w = b.y; return __builtin_bit_cast(bf16x8, w); }

typedef short v4i16_t __attribute__((ext_vector_type(4)));
__device__ __forceinline__ u32x2 tr_read(const LAS unsigned char* p) { return __builtin_bit_cast(u32x2, __builtin_amdgcn_ds_read_tr16_b64_v4i16((LAS v4i16_t*)p)); }
__device__ __forceinline__ int swz_f(int r) { return ((r & 3) << 2) | ((r >> 2) & 3); }

__device__ __forceinline__ void na_unit(LAS unsigned char* lds, const GAS bf16_t* QKV, GAS bf16_t* O, int ldo, const float* rpb_h, int tok0, int rows, int r0, int h, int tid, int lane, int wave) {
    LAS float* rp = (LAS float*)(lds + 147456);
    const int q = lane & 15, g = lane >> 4, qj = wave & 3, r = r0 + (wave >> 2);
    const int rsu = imin(imax(r0 - 4, 0), rows - 8), rs = imin(imax(r - 4, 0), rows - 8);
    const int kb_lo = qj == 0 ? 0 : qj - 1;
    const bool three = (qj == 1) || (qj == 2);
    const int tq = tok0 + r * 64 + 16 * qj + q;
    const int wbase = ((rs - rsu) * 64 + 16 * kb_lo) * 256;
    __syncthreads();
    if (tid < 465) rp[tid] = rpb_h[tid] * LOG2E;
    const int srow = lane >> 4, spos = (lane & 15) ^ (srow << 2);
#pragma unroll 2
    for (int i = 0; i < 18; ++i) {
        const int trow = 72 * wave + 4 * i, kr = trow >> 6, col = (trow & 63) + srow;
        const int tok = tok0 + imin(rsu + kr, rows - 1) * 64 + col;
        __builtin_amdgcn_global_load_lds((const unsigned*)(QKV + (size_t)tok * 6144 + 2048 + h * 128 + 8 * (spos ^ ((trow >> 2) & 3))), (LAS unsigned*)(lds + trow * 256), 16, 0, 0);
    }
    bf16x8 qf[4];
#pragma unroll
    for (int kk = 0; kk < 4; ++kk) qf[kk] = *(const GAS bf16x8*)(QKV + (size_t)tq * 6144 + h * 128 + 32 * kk + 8 * g);
    asm volatile("s_waitcnt vmcnt(0)" ::: "memory");
    __syncthreads();
    const int fk = swz_f(q);
    const LAS unsigned char* klane = lds + wbase + q * 256;
    f32x4 s[8][3];
#pragma unroll
    for (int a = 0; a < 8; ++a)
#pragma unroll
        for (int kbi = 0; kbi < 3; ++kbi) {
            f32x4 acc = (f32x4){0.f, 0.f, 0.f, 0.f};
            if (kbi < 2 || three) {
                const LAS unsigned char* kp = klane + (a * 64 + 16 * kbi) * 256;
#pragma unroll
                for (int kk = 0; kk < 4; ++kk) acc = __builtin_amdgcn_mfma_f32_16x16x32_bf16(*(const LAS bf16x8*)(kp + 16 * ((4 * kk + g) ^ fk)), qf[kk], acc, 0, 0, 0);
            }
            s[a][kbi] = acc;
        }
    const int cq = 16 * qj + q, cs = imin(imax(cq - 8, 0), 48);
    float mx = -1e30f;
#pragma unroll
    for (int a = 0; a < 8; ++a) {
        const LAS float* rpa = rp + (rs + a - r + 7) * 31;
#pragma unroll
        for (int kbi = 0; kbi < 3; ++kbi)
#pragma unroll
            for (int e = 0; e < 4; ++e) {
                const int ck = 16 * (kb_lo + kbi) + 4 * g + e;
                const bool valid = (kbi < 2 || three) && (ck >= cs) && (ck < cs + 16);
                const int dc = imin(imax(ck - cq + 15, 0), 30);
                const float v = valid ? s[a][kbi][e] * QK_SCALE2 + rpa[dc] : -1e30f;
                s[a][kbi][e] = v; mx = fmaxf(mx, v);
            }
    }
    mx = fmaxf(mx, __shfl_xor(mx, 16)); mx = fmaxf(mx, __shfl_xor(mx, 32));
    float sum = 0.f;
#pragma unroll
    for (int a = 0; a < 8; ++a)
#pragma unroll
        for (int kbi = 0; kbi < 3; ++kbi)
#pragma unroll
            for (int e = 0; e < 4; ++e) { const float p = __builtin_amdgcn_exp2f(s[a][kbi][e] - mx); s[a][kbi][e] = p; sum += p; }
    sum += __shfl_xor(sum, 16); sum += __shfl_xor(sum, 32);
    const float inv = 1.0f / sum;
    __syncthreads();
#pragma unroll 2
    for (int i = 0; i < 18; ++i) {
        const int trow = 72 * wave + 4 * i, kr = trow >> 6, col = (trow & 63) + srow;
        const int tok = tok0 + imin(rsu + kr, rows - 1) * 64 + col;
        __builtin_amdgcn_global_load_lds((const unsigned*)(QKV + (size_t)tok * 6144 + 4096 + h * 128 + 8 * (spos ^ ((trow >> 2) & 3))), (LAS unsigned*)(lds + trow * 256), 16, 0, 0);
    }
    asm volatile("s_waitcnt vmcnt(0)" ::: "memory");
    __syncthreads();
    f32x4 o[8];
#pragma unroll
    for (int dt = 0; dt < 8; ++dt) o[dt] = (f32x4){0.f, 0.f, 0.f, 0.f};
    const int qq = q >> 2, pp = lane & 3, fv = (qq << 2) | g;
    const LAS unsigned char* vlane = lds + wbase + (4 * g + qq) * 256 + 8 * (pp & 1);
    const f32x4 zero4 = (f32x4){0.f, 0.f, 0.f, 0.f};
#pragma unroll
    for (int a = 0; a < 8; ++a) {
        const LAS unsigned char* vx = vlane + (a * 64) * 256;
        const bf16x8 pf = pack8(s[a][0], s[a][1]);
#pragma unroll
        for (int dt = 0; dt < 8; ++dt) { const int co = 16 * ((2 * dt + (pp >> 1)) ^ fv);
            o[dt] = __builtin_amdgcn_mfma_f32_16x16x32_bf16(join8(tr_read(vx + co), tr_read(vx + 16 * 256 + co)), pf, o[dt], 0, 0, 0); }
        if (three) {
            const bf16x8 pf2 = pack8(s[a][2], zero4);
#pragma unroll
            for (int dt = 0; dt < 8; ++dt) { const int co = 16 * ((2 * dt + (pp >> 1)) ^ fv); const u32x2 x = tr_read(vx + 32 * 256 + co);
                o[dt] = __builtin_amdgcn_mfma_f32_16x16x32_bf16(join8(x, x), pf2, o[dt], 0, 0, 0); }
        }
    }
    GAS bf16_t* orow = O + (size_t)tq * ldo + h * 128;
#pragma unroll
    for (int dt = 0; dt < 8; ++dt) { const f32x4 v = o[dt] * inv; u32x2 w; w.x = cvt_pk_bf16(v[0], v[1]); w.y = cvt_pk_bf16(v[2], v[3]);
        *(GAS u32x2*)(orow + 16 * dt + 4 * g) = w; }
}

__device__ __forceinline__ void dil_unit(LAS unsigned char* lds, const GAS bf16_t* QKV, GAS bf16_t* O, int ldo, int colo, GAS float* LSE, const float* relb, int btok0, int grp, int sh, int L, int rho, int l0b, int h, int tid, int lane, int wave) {
    LAS float* bt = (LAS float*)(lds + 147456);
    const int q = lane & 15, g = lane >> 4;
    const int colq = grp * 3072 + h * 128;
    const int l0 = l0b + 16 * wave;
    const int tq = btok0 + ((l0 + q) << sh) + rho;
    __syncthreads();
    if (tid < 129) { const int rel = tid - 64, mag = rel < 0 ? -rel : rel; const int bucket = (rel > 0 ? 16 : 0) + T5_BUCKET[grp][mag];
        bt[tid] = relb[bucket * 24 + grp * 8 + h] * LOG2E; }
    const int srow = lane >> 4, spos = lane & 15;
#pragma unroll
    for (int i = 0; i < 8; ++i) {
        const int trow = 32 * wave + 4 * i + srow;
        const int lk = imin(imax(l0b - 64 + trow, 0), L - 1);
        const GAS bf16_t* src = QKV + (size_t)(btok0 + (lk << sh) + rho) * 9216 + colq + 8 * (spos ^ swz_f(trow));
        __builtin_amdgcn_global_load_lds((const unsigned*)(src + 1024), (LAS unsigned*)(lds + (32 * wave + 4 * i) * 256), 16, 0, 0);
        __builtin_amdgcn_global_load_lds((const unsigned*)(src + 2048), (LAS unsigned*)(lds + 65536 + (32 * wave + 4 * i) * 256), 16, 0, 0);
    }
    bf16x8 qf[4];
#pragma unroll
    for (int kk = 0; kk < 4; ++kk) qf[kk] = *(const GAS bf16x8*)(QKV + (size_t)tq * 9216 + colq + 32 * kk + 8 * g);
    asm volatile("s_waitcnt vmcnt(0)" ::: "memory");
    __syncthreads();
    const int fk = swz_f(q);
    f32x4 s[10];
#pragma unroll
    for (int kb = 0; kb < 9; ++kb) {
        const LAS unsigned char* kp = lds + (16 * wave + 16 * kb + q) * 256;
        f32x4 acc = (f32x4){0.f, 0.f, 0.f, 0.f};
#pragma unroll
        for (int kk = 0; kk < 4; ++kk) acc = __builtin_amdgcn_mfma_f32_16x16x32_bf16(*(const LAS bf16x8*)(kp + 16 * ((4 * kk + g) ^ fk)), qf[kk], acc, 0, 0, 0);
        s[kb] = acc;
    }
    s[9] = (f32x4){0.f, 0.f, 0.f, 0.f};
    float mx = -1e30f;
#pragma unroll
    for (int kb = 0; kb < 9; ++kb)
#pragma unroll
        for (int e = 0; e < 4; ++e) {
            const int rel = -64 + 16 * kb + 4 * g + e - q, lkey = l0 + q + rel;
            const bool valid = (rel >= -64) && (rel <= 64) && (lkey >= 0) && (lkey < L);
            const int bi = imin(imax(rel + 64, 0), 128);
            const float v = valid ? s[kb][e] * QK_SCALE2 + bt[bi] : -1e30f;
            s[kb][e] = v; mx = fmaxf(mx, v);
        }
    mx = fmaxf(mx, __shfl_xor(mx, 16)); mx = fmaxf(mx, __shfl_xor(mx, 32));
    float sum = 0.f;
#pragma unroll
    for (int kb = 0; kb < 9; ++kb)
#pragma unroll
        for (int e = 0; e < 4; ++e) { const float p = __builtin_amdgcn_exp2f(s[kb][e] - mx); s[kb][e] = p; sum += p; }
    sum += __shfl_xor(sum, 16); sum += __shfl_xor(sum, 32);
    const float inv = 1.0f / sum;
    if (g == 0) LSE[(size_t)tq * 24 + grp * 8 + h] = mx + __builtin_amdgcn_logf(sum);
    f32x4 o[8];
#pragma unroll
    for (int dt = 0; dt < 8; ++dt) o[dt] = (f32x4){0.f, 0.f, 0.f, 0.f};
    const int qq = q >> 2, pp = lane & 3, fv = (qq << 2) | g;
    const LAS unsigned char* vlane = lds + 65536 + (16 * wave + 4 * g + qq) * 256 + 8 * (pp & 1);
#pragma unroll
    for (int c = 0; c < 5; ++c) {
        const bf16x8 pf = pack8(s[2 * c], s[2 * c + 1]);
        const LAS unsigned char* vx = vlane + (32 * c) * 256;
        const int yo = (c == 4) ? 0 : 16 * 256;
#pragma unroll
        for (int dt = 0; dt < 8; ++dt) { const int co = 16 * ((2 * dt + (pp >> 1)) ^ fv);
            o[dt] = __builtin_amdgcn_mfma_f32_16x16x32_bf16(join8(tr_read(vx + co), tr_read(vx + yo + co)), pf, o[dt], 0, 0, 0); }
    }
    GAS bf16_t* orow = O + (size_t)tq * ldo + colo;
#pragma unroll
    for (int dt = 0; dt < 8; ++dt) { const f32x4 v = o[dt] * inv; u32x2 w; w.x = cvt_pk_bf16(v[0], v[1]); w.y = cvt_pk_bf16(v[2], v[3]);
        *(GAS u32x2*)(orow + 16 * dt + 4 * g) = w; }
}

__global__ void __launch_bounds__(NWAVES * 64, 2) fwd(Args args) {
    extern __shared__ __attribute__((aligned(16))) unsigned char lds_raw[];
    LAS unsigned char* lds = (LAS unsigned char*)lds_raw;
    volatile LAS unsigned* MISC = (volatile LAS unsigned*)(lds + MISC_OFF);
    const int G = gridDim.x, bx = blockIdx.x;
    const int vcu = (G % 8 == 0) ? (bx % 8) * (G / 8) + bx / 8 : bx;
    const int NGW = G * NWAVES;
    const int wave_k = __builtin_amdgcn_readfirstlane((int)threadIdx.x >> 6);
    { const int t0 = threadIdx.x; for (int u = t0; u < (LDS_BYTES - CTLZ_OFF) / 4; u += NWAVES * 64) ((LAS unsigned*)(lds + CTLZ_OFF))[u] = 0u; }
    __syncthreads();
    xcd_barrier_post((unsigned*)(args.ws + WS_CTL) + CW_BAR);
#define GRID_BAR() do { unsigned* b_ = (unsigned*)(args.ws + WS_CTL) + CW_BAR; asm volatile("" : "+s"(b_)); int w_ = wave_k; asm volatile("" : "+s"(w_)); \
    const bool ld_ = (w_ == 0) && (__builtin_amdgcn_mbcnt_hi(~0u, __builtin_amdgcn_mbcnt_lo(~0u, 0u)) == 0u); xcd_barrier(b_, MISC + 8, ld_); } while (0)
#define PHASE_LOCALS() int lane = (int)__builtin_amdgcn_mbcnt_hi(~0u, __builtin_amdgcn_mbcnt_lo(~0u, 0u)); asm volatile("" : "+v"(lane)); int wave = wave_k; asm volatile("" : "+s"(wave)); \
    const int tid = wave * 64 + lane; const int gw = vcu * NWAVES + wave; \
    unsigned char* ws = args.ws; asm volatile("" : "+s"(ws)); float* out = args.out; asm volatile("" : "+s"(out)); (void)tid; (void)gw; (void)out; \
    bf16_t* WGU = (bf16_t*)(ws + WS_WGU); bf16_t* WD = (bf16_t*)(ws + WS_WD); bf16_t* NAQKV = (bf16_t*)(ws + WS_NAQKV); bf16_t* NAO = (bf16_t*)(ws + WS_NAO); \
    bf16_t* DQKV = (bf16_t*)(ws + WS_DQKV); bf16_t* DOW = (bf16_t*)(ws + WS_DO); bf16_t* XB = (bf16_t*)(ws + WS_XB); bf16_t* BIG = (bf16_t*)(ws + WS_BIG); \
    float* LSE = (float*)(ws + WS_LSE); float* STATS = (float*)(ws + WS_STATS); float* C1 = (float*)(ws + WS_C1); float* C0 = (float*)(ws + WS_C0); (void)STATS; (void)C1; (void)C0; (void)WGU; (void)WD; (void)NAQKV; (void)NAO; (void)DQKV; (void)DOW; (void)XB; (void)BIG; (void)LSE;

    for (int rep = 0; rep < PROBE_P0; ++rep) {
        PHASE_LOCALS();
        LAS float* scr = (LAS float*)(lds + wave * 16384);
        constexpr int NFFN = 24 * 5632, NNAQ = 2 * 6144, NNAO = 2 * 2048, NDQ = 2 * 9216, NDO = 2 * 1024;
        constexpr int NITEMS = NFFN + NNAQ + NNAO + NDQ + NDO;
        for (int it = gw; it < NITEMS; it += NGW) {
            int r = it;
            if (r < NFFN) {
                const int m = r / 5632, rr = r - m * 5632, f = m / 3, kind = m - 3 * f;
                if (kind < 2) { const int kb = rr / 176, nb = rr - kb * 176, n0 = nb * 32;
                    const int slc = 3 * (f >> 1) + 2 * (f & 1);
                    transpose_item(args.in[4 + kind] + (size_t)f * DM * DFF, DM, DFF, WGU + (size_t)f * 2 * DFF * DM, (n0 >> 7) * 256 + (n0 & 127) + kind * 128, kb * 64, n0, scr, lane,
                                   slc ? args.in[2] + (size_t)(slc - 1) * DM : nullptr, args.in[3] + (size_t)(slc ? slc - 1 : 0) * DM, C1 + (size_t)slc * CSTRIDE, C0 + (size_t)slc * CSTRIDE); }
                else { const int kb = rr / 64, nb = rr - kb * 64, n0 = nb * 32;
                    transpose_item(args.in[6] + (size_t)f * DFF * DM, DFF, DM, WD + (size_t)f * DM * DFF, n0, kb * 64, n0, scr, lane, nullptr, nullptr, nullptr, nullptr); }
                continue;
            }
            r -= NFFN;
            if (r < NNAQ) { const int j = r / 6144, rr = r - j * 6144, kb = rr / 192, nb = rr - kb * 192, n0 = nb * 32;
                transpose_item(args.in[7] + (size_t)j * DM * 6144, DM, 6144, NAQKV + (size_t)j * 6144 * DM, n0, kb * 64, n0, scr, lane, args.in[2] + (size_t)(6 * j) * DM, args.in[3] + (size_t)(6 * j) * DM, C1 + (size_t)(6 * j + 1) * CSTRIDE, C0 + (size_t)(6 * j + 1) * CSTRIDE); continue; }
            r -= NNAQ;
            if (r < NNAO) { const int j = r / 2048, rr = r - j * 2048, kb = rr / 64, nb = rr - kb * 64, n0 = nb * 32;
                transpose_item(args.in[8] + (size_t)j * DM * DM, DM, DM, NAO + (size_t)j * DM * DM, n0, kb * 64, n0, scr, lane, nullptr, nullptr, nullptr, nullptr); continue; }
            r -= NNAO;
            if (r < NDQ) { const int j = r / 9216, rr = r - j * 9216, kb = rr / 288, nb = rr - kb * 288, n0 = nb * 32;
                transpose_item(args.in[10] + (size_t)j * DM * 9216, DM, 9216, DQKV + (size_t)j * 9216 * DM, n0, kb * 64, n0, scr, lane, args.in[2] + (size_t)(6 * j + 3) * DM, args.in[3] + (size_t)(6 * j + 3) * DM, C1 + (size_t)(6 * j + 4) * CSTRIDE, C0 + (size_t)(6 * j + 4) * CSTRIDE); continue; }
            r -= NDQ;
            { const int j = r / 1024, rr = r - j * 1024, kb = rr / 64, nb = rr - kb * 64, n0 = nb * 32;
                transpose_item(args.in[11] + (size_t)j * 1024 * DM, 1024, DM, DOW + (size_t)j * DM * 1024, n0, kb * 64, n0, scr, lane, nullptr, nullptr, nullptr, nullptr); }
        }
        for (int m = gw; m < MTOK; m += NGW) {
            const float* src = m < PROMPT_TOK ? args.in[0] + (size_t)m * DM : args.in[1] + (size_t)(m - PROMPT_TOK) * DM;
            const GAS f32x4* xr = (const GAS f32x4*)src + lane; GAS f32x4* orow = (GAS f32x4*)(out + (size_t)m * DM) + lane; GAS u32x2* brow = (GAS u32x2*)(XB + (size_t)m * DM) + lane;
#pragma unroll
            for (int j = 0; j < 8; ++j) { const f32x4 v = xr[64 * j]; orow[64 * j] = v; u32x2 w; w.x = cvt_pk_bf16(v[0], v[1]); w.y = cvt_pk_bf16(v[2], v[3]); brow[64 * j] = w; }
        }
    }
    GRID_BAR();

    for (int sl = 0; sl < 12; ++sl) {
        const int li = sl / 3, kind = sl - 3 * li;
        PHASE_LOCALS();
        const bf16_t* Ares; int lda_res, Kres; const bf16_t* Wres; float sres;
        const float* stats_old = sl ? STATS + (size_t)(sl - 1) * MTOK * 2 : nullptr;
        const pg8::LnFold FOLD{stats_old, C1 + (size_t)sl * CSTRIDE, C0 + (size_t)sl * CSTRIDE};
        bf16_t* SCR = (bf16_t*)(ws + WS_END); (void)SCR;
        if (kind != 1) {
            const int f = li * 2 + (kind >> 1);
            for (int rep = 0; rep < PROBE_GU; ++rep) {
            { pg8::Gemm g{XB, DM, DM}; pg8::BPlain B{WGU + (size_t)f * 2 * DFF * DM, DM}; pg8::StaticOrder S; S.init(MTOK, 2 * DFF, G, bx); pg8::EpiSwiGLU E{BIG, DFF, FOLD};
              pg8::gemm_phase<pg8::EpiSwiGLU, pg8::BPlain>(lds, g, B, S, E, tid); }
            GRID_BAR();
            }
            Ares = BIG; lda_res = DFF; Kres = DFF; Wres = WD + (size_t)f * DM * DFF; sres = 0.5f;
        } else if ((li & 1) == 0) {
            const int j = li >> 1;
            bf16_t* QKVB = BIG;
            for (int rep = 0; rep < PROBE_QKV; ++rep) {
            { pg8::Gemm g{XB, DM, DM}; pg8::BPlain B{NAQKV + (size_t)j * 6144 * DM, DM}; pg8::StaticOrder S; S.init(MTOK, 6144, G, bx); pg8::EpiBf16P E{QKVB, 6144, FOLD};
              pg8::gemm_phase<pg8::EpiBf16P, pg8::BPlain>(lds, g, B, S, E, tid); }
            GRID_BAR();
            }
            for (int rep = PROBE_ATT - 1; rep >= 0; --rep) {
                const float* rpb = args.in[9] + (size_t)j * 16 * 465;
                GAS bf16_t* O = rep ? (GAS bf16_t*)SCR : (GAS bf16_t*)QKVB; const int ldo = rep ? 2048 : 6144;
                for (int id = vcu; id < 4096; id += G) {
                    int tok0, rows, h, pair;
                    if (id < 2048) { const int img = id >> 8, rem = id & 255; h = rem >> 4; pair = rem & 15; rows = 32; tok0 = img * 2048; }
                    else { const int i2 = id - 2048, img = i2 >> 9, rem = i2 & 511; h = rem >> 5; pair = rem & 31; rows = 64; tok0 = PROMPT_TOK + img * 4096; }
                    na_unit(lds, (const GAS bf16_t*)QKVB, O, ldo, rpb + h * 465, tok0, rows, 2 * pair, h, tid, lane, wave);
                }
                GRID_BAR();
            }
            Ares = QKVB; lda_res = 6144; Kres = DM; Wres = NAO + (size_t)j * DM * DM; sres = 1.0f;
        } else {
            const int j = li >> 1;
            bf16_t* QKVB = BIG;
            for (int rep = 0; rep < PROBE_QKV; ++rep) {
            { pg8::Gemm g{XB, DM, DM}; pg8::BPlain B{DQKV + (size_t)j * 9216 * DM, DM}; pg8::StaticOrder S; S.init(MTOK, 9216, G, bx); pg8::EpiBf16P E{QKVB, 9216, FOLD};
              pg8::gemm_phase<pg8::EpiBf16P, pg8::BPlain>(lds, g, B, S, E, tid); }
            GRID_BAR();
            }
            for (int rep = PROBE_ATT - 1; rep >= 0; --rep) {
                GAS bf16_t* O = rep ? (GAS bf16_t*)SCR : (GAS bf16_t*)QKVB; const int ldo = rep ? 3072 : 9216, gstride = rep ? 1024 : 3072;
                for (int id = vcu; id < 6144; id += G) {
                    const int gh = id >> 8, pb = id & 255, grp = gh >> 3, h = gh & 7, sh = 2 * grp;
                    int T, btok0, pp;
                    if (pb < 128) { T = 2048; btok0 = (pb >> 4) * 2048; pp = (pb & 15) * 128; }
                    else { T = 4096; btok0 = PROMPT_TOK + ((pb - 128) >> 5) * 4096; pp = ((pb - 128) & 31) * 128; }
                    const int L = T >> sh, rho = pp / L, l0b = pp - rho * L;
                    dil_unit(lds, (const GAS bf16_t*)QKVB, O, ldo, grp * gstride + h * 128, (GAS float*)LSE, args.in[12], btok0, grp, sh, L, rho, l0b, h, tid, lane, wave);
                }
                GRID_BAR();
            }
            for (int rep = PROBE_ATT - 1; rep >= 0; --rep) {
            GAS bf16_t* MO = rep ? (GAS bf16_t*)SCR : (GAS bf16_t*)QKVB; const int ldm = rep ? 1024 : 9216;
            for (int tok = gw; tok < MTOK; tok += NGW) {
                const int h = lane >> 3, c16 = (lane & 7) * 16;
                const GAS float* lp = (const GAS float*)LSE + (size_t)tok * 24 + h;
                const float l0 = lp[0], l1 = lp[8], l2 = lp[16];
                const float m = fmaxf(l0, fmaxf(l1, l2));
                float w0 = __builtin_amdgcn_exp2f(l0 - m), w1 = __builtin_amdgcn_exp2f(l1 - m), w2 = __builtin_amdgcn_exp2f(l2 - m);
                const float inv = 1.0f / (w0 + w1 + w2); w0 *= inv; w1 *= inv; w2 *= inv;
                const GAS bf16_t* base = (const GAS bf16_t*)QKVB + (size_t)tok * 9216 + h * 128 + c16;
                GAS bf16_t* obase = MO + (size_t)tok * ldm + h * 128 + c16;
#pragma unroll
                for (int hf = 0; hf < 2; ++hf) {
                    const u32x4 a0 = *(const GAS u32x4*)(base + hf * 8), a1 = *(const GAS u32x4*)(base + 3072 + hf * 8), a2 = *(const GAS u32x4*)(base + 6144 + hf * 8);
                    u32x4 w;
#pragma unroll
                    for (int k = 0; k < 4; ++k) {
                        const float lo = w0 * bf_lo(a0[k]) + w1 * bf_lo(a1[k]) + w2 * bf_lo(a2[k]);
                        const float hi = w0 * bf_hi(a0[k]) + w1 * bf_hi(a1[k]) + w2 * bf_hi(a2[k]);
                        w[k] = cvt_pk_bf16(lo, hi);
                    }
                    *(GAS u32x4*)(obase + hf * 8) = w;
                }
            }
            GRID_BAR();
            }
            Ares = QKVB; lda_res = 9216; Kres = 1024; Wres = DOW + (size_t)j * DM * 1024; sres = 1.0f;
        }
        { pg8::Gemm g{Ares, lda_res, Kres}; pg8::BPlain B{Wres, Kres}; pg8::StaticOrder S; S.init(MTOK, DM, G, bx);
          pg8::EpiResidLn E{out, XB, DM, ALPHA, sres, stats_old, args.in[2] + (size_t)(sl ? sl - 1 : 0) * DM, args.in[3] + (size_t)(sl ? sl - 1 : 0) * DM, STATS + (size_t)sl * MTOK * 2};
          pg8::gemm_phase<pg8::EpiResidLn, pg8::BPlain>(lds, g, B, S, E, tid); }
        GRID_BAR();
    }
    {
        PHASE_LOCALS();
        const GAS f32x4* gp = (const GAS f32x4*)(args.in[2] + (size_t)11 * DM) + lane; const GAS f32x4* bp = (const GAS f32x4*)(args.in[3] + (size_t)11 * DM) + lane;
        for (int m = gw; m < MTOK; m += NGW) {
            GAS f32x4* yr = (GAS f32x4*)(out + (size_t)m * DM) + lane;
            f32x4 v[8]; float sm = 0.f;
#pragma unroll
            for (int jj = 0; jj < 8; ++jj) { v[jj] = yr[64 * jj]; sm += (v[jj][0] + v[jj][1]) + (v[jj][2] + v[jj][3]); }
            const float mean = wave_sum(sm) * (1.f / DM); float s2 = 0.f;
#pragma unroll
            for (int jj = 0; jj < 8; ++jj) { v[jj] = v[jj] - mean; s2 += (v[jj][0] * v[jj][0] + v[jj][1] * v[jj][1]) + (v[jj][2] * v[jj][2] + v[jj][3] * v[jj][3]); }
            const float rstd = 1.f / sqrtf(wave_sum(s2) * (1.f / DM) + LN_EPS);
#pragma unroll
            for (int jj = 0; jj < 8; ++jj) yr[64 * jj] = v[jj] * rstd * gp[64 * jj] + bp[64 * jj];
        }
    }
#undef GRID_BAR
}

extern "C" void kernel_launch(void* const* d_in, const int* in_sizes, int n_in, void* d_out, int out_size, void* d_ws, size_t ws_size, hipStream_t stream) {
    static int grid = 0;
    if (grid == 0) {
        if (n_in != 13 || out_size != MTOK * DM || ws_size < WS_END + (size_t)((PROBE_ATT > 1) ? (size_t)MTOK * 3072 * 2 : 0)) { fprintf(stderr, "kernel_launch: unexpected shapes (n_in %d, out %d, ws %zu < %zu); nothing launched\n", n_in, out_size, ws_size, (size_t)WS_END); grid = -1; return; }
        int dev = 0, cus = 0, per_cu = 0;
        if (hipGetDevice(&dev) != hipSuccess || hipDeviceGetAttribute(&cus, hipDeviceAttributeMultiprocessorCount, dev) != hipSuccess) { grid = -1; return; }
        if (hipFuncSetAttribute((const void*)fwd, hipFuncAttributeMaxDynamicSharedMemorySize, LDS_BYTES) != hipSuccess) { fprintf(stderr, "kernel_launch: hipFuncSetAttribute failed\n"); grid = -1; return; }
        if (hipOccupancyMaxActiveBlocksPerMultiprocessor(&per_cu, (const void*)fwd, NWAVES * 64, LDS_BYTES) != hipSuccess || per_cu < 1)
            fprintf(stderr, "kernel_launch: note: occupancy query reports %d workgroups per CU\n", per_cu);
        (void)hipGetLastError();
        grid = cus;
    }
    if (grid < 0) return;
    if (hipMemsetAsync((char*)d_ws + WS_CTL, 0, CTL_ZERO_BYTES, stream) != hipSuccess) { fprintf(stderr, "kernel_launch: memset failed\n"); return; }
    Args a{};
    for (int i = 0; i < 13; ++i) a.in[i] = (const float*)d_in[i];
    a.out = (float*)d_out; a.ws = (unsigned char*)d_ws;
    hipLaunchKernelGGL(fwd, dim3(grid), dim3(NWAVES * 64), LDS_BYTES, stream, a);
    const hipError_t le = hipPeekAtLastError();
    if (le != hipSuccess) fprintf(stderr, "kernel_launch: launch failed: %s\n", hipGetErrorName(le));
}
```

```cpp
#include <hip/hip_runtime.h>
#include <cstdio>
#include <cstdint>

#define GAS __attribute__((address_space(1)))
#define LAS __attribute__((address_space(3)))
typedef unsigned short bf16_t;
typedef short bf16x8 __attribute__((ext_vector_type(8)));
typedef float f32x4 __attribute__((ext_vector_type(4)));
typedef unsigned u32x4 __attribute__((ext_vector_type(4)));
typedef unsigned u32x2 __attribute__((ext_vector_type(2)));
typedef float f32x2 __attribute__((ext_vector_type(2)));

#ifndef PROBE_GU
#define PROBE_GU 1
#endif
#ifndef PROBE_QKV
#define PROBE_QKV 1
#endif
#ifndef PROBE_ATT
#define PROBE_ATT 1
#endif
#ifndef PROBE_LN
#define PROBE_LN 1
#endif
#ifndef PROBE_IDLE
#define PROBE_IDLE 0
#endif
#ifndef STAG_US
#define STAG_US 0
#endif
#ifndef PROBE_RESK
#define PROBE_RESK 0
#endif
#ifndef PROBE_P0
#define PROBE_P0 1
#endif
constexpr int DM = 2048, DFF = 5632;
constexpr int MTOK = 32768, PROMPT_TOK = 16384;
constexpr float ALPHA = 1.6817928305074290f;
constexpr float LN_EPS = 1e-5f;
constexpr float LOG2E = 1.4426950408889634f;
constexpr float QK_SCALE2 = 0.08838834764831845f * 1.4426950408889634f;

__device__ __forceinline__ unsigned cvt_pk_bf16(float lo, float hi) { unsigned r; asm volatile("v_cvt_pk_bf16_f32 %0, %1, %2" : "=v"(r) : "v"(lo), "v"(hi)); return r; }
__device__ __forceinline__ float bf_lo(unsigned w) { return __builtin_bit_cast(float, w << 16); }
__device__ __forceinline__ float bf_hi(unsigned w) { return __builtin_bit_cast(float, w & 0xffff0000u); }
__device__ __forceinline__ int lane_id_fresh() { int l; asm volatile("v_mbcnt_lo_u32_b32 %0, -1, 0\n\tv_mbcnt_hi_u32_b32 %0, -1, %0" : "=&v"(l)); return l; }
constexpr float LO_SCALE = 512.f, LO_INV = 1.f / 512.f;
__device__ __forceinline__ unsigned lo8_pack4(float a, float b, float c, float d) { int v = __builtin_amdgcn_cvt_pk_fp8_f32(a * LO_SCALE, b * LO_SCALE, 0, false); v = __builtin_amdgcn_cvt_pk_fp8_f32(c * LO_SCALE, d * LO_SCALE, v, true); return (unsigned)v; }
__device__ __forceinline__ unsigned lo8_pack4s(float a, float b, float c, float d) { int v = __builtin_amdgcn_cvt_pk_fp8_f32(a, b, 0, false); v = __builtin_amdgcn_cvt_pk_fp8_f32(c, d, v, true); return (unsigned)v; }
__device__ __forceinline__ f32x4 lo8_unpack4(unsigned v) { const auto a = __builtin_amdgcn_cvt_pk_f32_fp8((int)v, false), b = __builtin_amdgcn_cvt_pk_f32_fp8((int)v, true); return (f32x4){a[0], a[1], b[0], b[1]} * LO_INV; }
__device__ __forceinline__ size_t lo_rec(int pm, int pn, int wr, int wc, int fr, int fq) { return ((size_t)(pm * 8 + pn) * 8 + (wr * 4 + wc)) * 8192 + (size_t)(fq * 16 + fr) * 16; }
__device__ __forceinline__ size_t lo_rowcol(int row, int j, int lane) {
    const int pm = row >> 8, r = row & 255, ai = r >> 7, wr = (r >> 6) & 1, mm = (r >> 4) & 3, fr = r & 15;
    const int bj = lane >> 5, wc = (lane >> 3) & 3, fq = (lane >> 1) & 3, n = lane & 1;
    return lo_rec(pm, j, wr, wc, fr, fq) + (size_t)((ai * 4 + mm) * 1024 + bj * 8 + n * 4);
}
__device__ __forceinline__ int imin(int a, int b) { return a < b ? a : b; }
__device__ __forceinline__ int imax(int a, int b) { return a > b ? a : b; }

namespace pg8 {
constexpr int BM = 256, BK = 64, HALF = 128, HTB = HALF * BK * 2  , STAGE_BYTES = 8 * HTB, NXCD = 8, WGM = 8;
__host__ __device__ __forceinline__ int lds_byte(int r, int c) { const int st = (r >> 4) * 2 + (c >> 5), rr = r & 15, cc = c & 31, ob = rr * 64 + cc * 2; return st * 1024 + (ob ^ (((ob >> 9) & 1) << 5)); }
__host__ __device__ __forceinline__ void stage_rc(int b, int& R, int& C) { const int st = b / 1024, sb = b % 1024, swz = sb ^ (((sb >> 9) & 1) << 5); R = (st >> 1) * 16 + swz / 64; C = (st & 1) * 32 + (swz % 64) / 2; }
__host__ __device__ __forceinline__ int perm32(int rho) { const int n = rho >> 4, i = rho & 15; return 8 * (i >> 2) + 4 * n + (i & 3); }

struct Unit { int pm, pn; };
struct Gemm { const bf16_t* A; int lda; int K; int tiled; };
__host__ __device__ __forceinline__ int lds_byte(int r, int c);
__device__ __forceinline__ size_t atile_byte(int row, int col, int lda) { const int rl = row & 255;
    return ((((size_t)(row >> 8) * (lda >> 6)) + (col >> 6)) * 2 + (rl >> 7)) * 16384 + (size_t)lds_byte(rl & 127, col & 63); }

struct StaticOrder {
    int nM, nN, nwg, G, c;
    __device__ void init(int M, int N, int G_, int c_) { nM = M / BM; nN = N / BM; nwg = nM * nN; G = G_; c = c_; }
    __device__ bool next(int i, Unit& u) const {
        const long L = (long)i * G + c; if (L >= nwg) return false;
        int wgid = (int)L; { const int q = nwg / NXCD, r = nwg % NXCD, xcd = wgid % NXCD, off = wgid / NXCD; wgid = (xcd < r ? xcd * (q + 1) : r * (q + 1) + (xcd - r) * q) + off; }
        const int nig = WGM * nN, gid = wgid / nig, fm = gid * WGM, gsz = (nM - fm) < WGM ? (nM - fm) : WGM;
        u.pm = fm + ((wgid % nig) % gsz); u.pn = (wgid % nig) / gsz; return true;
    }
};
constexpr int GS = 4;
struct PanelOrder {
    int per, tot, pm0, pn0;
    __device__ void init(int, int N, int, int c) { per = (N / BM) / GS; tot = (GS / 2) * per; pm0 = (c / GS) * (GS / 2); pn0 = (c % GS) * per; }
    __device__ bool next(int i, Unit& u) const { if (i >= tot) return false; const int q = i / per; u.pm = pm0 + q; u.pn = pn0 + (i - q * per); return true; }
};
struct BPlain { const bf16_t* Bt; int K;
    __device__ __forceinline__ const char* half(const Unit& u, int hh) const { return (const char*)Bt + ((size_t)u.pn * (K / BK) * 2 + hh) * 16384; } };
__device__ __forceinline__ size_t wtile_byte(int n, int k, int K) {
    const int pn = n >> 8, nl = n & 255, h = nl >> 7, r128 = nl & 127, gq = r128 >> 5, cc = r128 & 31;
    const int rho = ((cc >> 2) & 1) * 16 + ((cc >> 3) << 2) + (cc & 3);
    return (((size_t)pn * (K / BK) + (k >> 6)) * 2 + h) * 16384 + (size_t)lds_byte(gq * 32 + rho, k & 63);
}
struct LnFold { const float* stats; const float* c1; const float* c0;
    __device__ __forceinline__ void row(int r, float& mu, float& rstd) const {
        if (stats) { const f32x2 st = *(const f32x2*)(stats + 2 * (size_t)r); mu = st.x * (1.0f / DM); rstd = __builtin_amdgcn_rsqf(fmaxf(st.y * (1.0f / DM) - mu * mu, 0.f) + LN_EPS);     } else { mu = 0.f; rstd = 1.f; } }
    static constexpr int TBL_OFF = 131072, TBL_BYTES = 4096;
    __device__ __forceinline__ void prefetch(LAS unsigned char* lds, int par, int row0u, int col0u, int wid, int lane) const {
        LAS unsigned char* t = lds + TBL_OFF + par * TBL_BYTES;
        if (stats) __builtin_amdgcn_global_load_lds((const unsigned*)(stats + 2 * (size_t)(row0u + 32 * wid) + lane), (LAS unsigned*)(t + wid * 256), 4, 0, 0);
        const float* cs = (wid < 4 ? c1 : c0) + col0u + 64 * (wid & 3) + lane;
        __builtin_amdgcn_global_load_lds((const unsigned*)cs, (LAS unsigned*)(t + 2048 + wid * 256), 4, 0, 0);
    }
    __device__ __forceinline__ void row_lds(const LAS unsigned char* lds, int par, int rl, float& mu, float& rstd) const {
        if (stats) { const f32x2 st = *(const LAS f32x2*)(lds + TBL_OFF + par * TBL_BYTES + 8 * rl); mu = st.x * (1.0f / DM); rstd = __builtin_amdgcn_rsqf(fmaxf(st.y * (1.0f / DM) - mu * mu, 0.f) + LN_EPS);     } else { mu = 0.f; rstd = 1.f; } }
    __device__ __forceinline__ f32x4 c1_lds(const LAS unsigned char* lds, int par, int cl) const { return *(const LAS f32x4*)(lds + TBL_OFF + par * TBL_BYTES + 2048 + 4 * cl); }
    __device__ __forceinline__ f32x4 c0_lds(const LAS unsigned char* lds, int par, int cl) const { return *(const LAS f32x4*)(lds + TBL_OFF + par * TBL_BYTES + 3072 + 4 * cl); }
};
struct EpiBf16P {
    static constexpr bool PERM = true;
    bf16_t* O; int ldc; LnFold F;
    __device__ __forceinline__ void prefetch(LAS unsigned char* lds, int par, const Unit& u, int wid, int lane) const { F.prefetch(lds, par, u.pm * BM, u.pn * BM, wid, lane); }
    __device__ __forceinline__ void init(f32x4 (&acc)[2][2][4][2], const Unit&, int, int, int, int) const {
#pragma unroll
        for (int a = 0; a < 2; ++a)
#pragma unroll
            for (int b = 0; b < 2; ++b)
#pragma unroll
                for (int m = 0; m < 4; ++m)
#pragma unroll
                    for (int n = 0; n < 2; ++n) acc[a][b][m][n] = (f32x4){0.f, 0.f, 0.f, 0.f};
    }
    __device__ __forceinline__ void operator()(const f32x4 (&acc)[2][2][4][2], const Unit& u, int wr, int wc, int fr, int fq, const LAS unsigned char* lds, int par) const {
        const int row0 = u.pm * BM + wr * 64 + fr, col0 = u.pn * BM + wc * 32 + 8 * fq;
        float mu[8], rstd[8];
#pragma unroll
        for (int i = 0; i < 8; ++i) F.row_lds(lds, par, wr * 64 + fr + (i >> 2) * HALF + (i & 3) * 16, mu[i], rstd[i]);
        f32x4 c1v[2][2], c0v[2][2];
#pragma unroll
        for (int bj = 0; bj < 2; ++bj)
#pragma unroll
            for (int n = 0; n < 2; ++n) { c1v[bj][n] = F.c1_lds(lds, par, wc * 32 + 8 * fq + bj * HALF + 4 * n); c0v[bj][n] = F.c0_lds(lds, par, wc * 32 + 8 * fq + bj * HALF + 4 * n); }
#pragma unroll
        for (int ai = 0; ai < 2; ++ai)
#pragma unroll
            for (int m = 0; m < 4; ++m) { const int row = row0 + ai * HALF + m * 16; bf16_t* rowp = O + (size_t)row * ldc + col0;
                const float mu_ = mu[ai * 4 + m], rs_ = rstd[ai * 4 + m];
#pragma unroll
                for (int bj = 0; bj < 2; ++bj) { const f32x4 v0 = (acc[ai][bj][m][0] - c1v[bj][0] * mu_) * rs_ + c0v[bj][0], v1 = (acc[ai][bj][m][1] - c1v[bj][1] * mu_) * rs_ + c0v[bj][1];
                    u32x4 w; w.x = cvt_pk_bf16(v0[0], v0[1]); w.y = cvt_pk_bf16(v0[2], v0[3]); w.z = cvt_pk_bf16(v1[0], v1[1]); w.w = cvt_pk_bf16(v1[2], v1[3]);
                    *(u32x4*)(rowp + bj * HALF) = w; } }
    }
};
__device__ __forceinline__ float silu_mul(float gs, float u) { return gs * u * __builtin_amdgcn_rcpf(1.0f + __builtin_amdgcn_exp2f(gs)); }
__device__ __forceinline__ f32x4 silu_mul4(const f32x4 gs, const f32x4 u) {
    const f32x4 e = (f32x4){__builtin_amdgcn_exp2f(gs[0]), __builtin_amdgcn_exp2f(gs[1]), __builtin_amdgcn_exp2f(gs[2]), __builtin_amdgcn_exp2f(gs[3])} + 1.0f;
    const f32x4 r = {__builtin_amdgcn_rcpf(e[0]), __builtin_amdgcn_rcpf(e[1]), __builtin_amdgcn_rcpf(e[2]), __builtin_amdgcn_rcpf(e[3])};
    return (gs * u) * r;
}
struct EpiSwiGLU {
    static constexpr bool PERM = true;
    bf16_t* H; int ldc; LnFold F;
    __device__ __forceinline__ void prefetch(LAS unsigned char* lds, int par, const Unit& u, int wid, int lane) const { F.prefetch(lds, par, u.pm * BM, u.pn * BM, wid, lane); }
    __device__ __forceinline__ void init(f32x4 (&acc)[2][2][4][2], const Unit&, int, int, int, int) const {
#pragma unroll
        for (int a = 0; a < 2; ++a)
#pragma unroll
            for (int b = 0; b < 2; ++b)
#pragma unroll
                for (int m = 0; m < 4; ++m)
#pragma unroll
                    for (int n = 0; n < 2; ++n) acc[a][b][m][n] = (f32x4){0.f, 0.f, 0.f, 0.f};
    }
    __device__ __forceinline__ void operator()(const f32x4 (&acc)[2][2][4][2], const Unit& u, int wr, int wc, int fr, int fq, const LAS unsigned char* lds, int par) const {
        const int row0 = u.pm * BM + wr * 64 + fr, col0 = u.pn * HALF + wc * 32 + 8 * fq, ccol0 = u.pn * BM + wc * 32 + 8 * fq;
        float mu[8], rstd[8];
#pragma unroll
        for (int i = 0; i < 8; ++i) F.row_lds(lds, par, wr * 64 + fr + (i >> 2) * HALF + (i & 3) * 16, mu[i], rstd[i]);
        f32x4 c1v[2][2], c0v[2][2];
#pragma unroll
        for (int bj = 0; bj < 2; ++bj)
#pragma unroll
            for (int n = 0; n < 2; ++n) { c1v[bj][n] = F.c1_lds(lds, par, wc * 32 + 8 * fq + bj * HALF + 4 * n); c0v[bj][n] = F.c0_lds(lds, par, wc * 32 + 8 * fq + bj * HALF + 4 * n); }
#pragma unroll
        for (int ai = 0; ai < 2; ++ai)
#pragma unroll
            for (int m = 0; m < 4; ++m) { const int row = row0 + ai * HALF + m * 16; bf16_t* rowp = (bf16_t*)((unsigned char*)H + atile_byte(row, col0, ldc));
                const float mu_ = mu[ai * 4 + m], rs_ = rstd[ai * 4 + m];
                const f32x4 g0 = (acc[ai][0][m][0] - c1v[0][0] * mu_) * rs_ + c0v[0][0], g1 = (acc[ai][0][m][1] - c1v[0][1] * mu_) * rs_ + c0v[0][1];
                const f32x4 u0 = (acc[ai][1][m][0] - c1v[1][0] * mu_) * rs_ + c0v[1][0], u1 = (acc[ai][1][m][1] - c1v[1][1] * mu_) * rs_ + c0v[1][1];
                const f32x4 s0 = silu_mul4(g0, u0), s1 = silu_mul4(g1, u1);
                u32x4 w; w.x = cvt_pk_bf16(s0[0], s0[1]); w.y = cvt_pk_bf16(s0[2], s0[3]); w.z = cvt_pk_bf16(s1[0], s1[1]); w.w = cvt_pk_bf16(s1[2], s1[3]);
                *(u32x4*)rowp = w; }
    }
};
struct EpiResidLn {
    static constexpr bool PERM = true;
    bf16_t* YH; unsigned char* YL; int ldc; float alpha, s; const float* stats_old; const float* g_old; const float* b_old; float* stats_new; bf16_t* YHo = nullptr; unsigned char* YLo = nullptr;
    __device__ __forceinline__ void prefetch(LAS unsigned char*, int, const Unit&, int, int) const {}
#define RL_LD16(dst_, ptr_) asm volatile("global_load_dwordx4 %0, %1, off" : "=v"(dst_) : "v"((const GAS void*)(ptr_)) : "memory")
#define RL_LD8(dst_, ptr_)  asm volatile("global_load_dwordx2 %0, %1, off" : "=v"(dst_) : "v"((const GAS void*)(ptr_)) : "memory")
    __device__ __forceinline__ void init(f32x4 (&acc)[2][2][4][2], const Unit& u, int wr, int wc, int fr, int fq) const {
        const int row0 = u.pm * BM + wr * 64 + fr, col0 = u.pn * BM + wc * 32 + 8 * fq;
        f32x2 st[8];
        const float* sp = stats_old ? stats_old : stats_new;
#pragma unroll
        for (int i = 0; i < 8; ++i) RL_LD8(st[i], sp + 2 * (size_t)(row0 + (i >> 2) * HALF + (i & 3) * 16));
        f32x4 gl[2][2], bl[2][2];
#pragma unroll
        for (int bj = 0; bj < 2; ++bj)
#pragma unroll
            for (int n = 0; n < 2; ++n) { RL_LD16(gl[bj][n], g_old + col0 + bj * HALF + 4 * n); RL_LD16(bl[bj][n], b_old + col0 + bj * HALF + 4 * n); }
        const unsigned char* lrec = YL + lo_rec(u.pm, u.pn, wr, wc, fr, fq);
        u32x4 L[8], H0[8], H1[8];
#pragma unroll
        for (int i = 0; i < 8; ++i) { const int ai = i >> 2, m = i & 3; const int row = row0 + ai * HALF + m * 16;
            RL_LD16(L[i], lrec + i * 1024); RL_LD16(H0[i], (const unsigned char*)YH + atile_byte(row, col0, ldc)); RL_LD16(H1[i], (const unsigned char*)YH + atile_byte(row, col0 + HALF, ldc)); }
        asm volatile("s_waitcnt vmcnt(24)" : "+v"(st[0]), "+v"(st[1]), "+v"(st[2]), "+v"(st[3]), "+v"(st[4]), "+v"(st[5]), "+v"(st[6]), "+v"(st[7]),
                     "+v"(gl[0][0]), "+v"(gl[0][1]), "+v"(gl[1][0]), "+v"(gl[1][1]), "+v"(bl[0][0]), "+v"(bl[0][1]), "+v"(bl[1][0]), "+v"(bl[1][1]) :: "memory");
        const float k = alpha / s;
        f32x4 gv[2][2], bv[2][2];
#pragma unroll
        for (int bj = 0; bj < 2; ++bj)
#pragma unroll
            for (int n = 0; n < 2; ++n) { gv[bj][n] = stats_old ? gl[bj][n] * k : (f32x4){k, k, k, k}; bv[bj][n] = stats_old ? bl[bj][n] * k : (f32x4){0.f, 0.f, 0.f, 0.f}; }
#define RL_GROUP(i_, cnt_) do { constexpr int ai = (i_) >> 2, m = (i_) & 3; \
            asm volatile("s_waitcnt vmcnt(" #cnt_ ")" : "+v"(L[i_]), "+v"(H0[i_]), "+v"(H1[i_]) :: "memory"); \
            const float mus = st[i_].x * (1.0f / DM), rss = __builtin_amdgcn_rsqf(fmaxf(st[i_].y * (1.0f / DM) - mus * mus, 0.f) + LN_EPS); \
            const float mu_ = stats_old ? mus : 0.f, rs_ = stats_old ? rss : 1.f; \
            _Pragma("unroll") for (int bj = 0; bj < 2; ++bj) { const u32x4 h = bj ? H1[i_] : H0[i_]; \
                const f32x4 y0 = (f32x4){bf_lo(h.x), bf_hi(h.x), bf_lo(h.y), bf_hi(h.y)} + lo8_unpack4(bj ? L[i_].z : L[i_].x); \
                const f32x4 y1 = (f32x4){bf_lo(h.z), bf_hi(h.z), bf_lo(h.w), bf_hi(h.w)} + lo8_unpack4(bj ? L[i_].w : L[i_].y); \
                const f32x4 gr0 = gv[bj][0] * rs_, gr1 = gv[bj][1] * rs_;                    \
                acc[ai][bj][m][0] = y0 * gr0 + (bv[bj][0] - gr0 * mu_); acc[ai][bj][m][1] = y1 * gr1 + (bv[bj][1] - gr1 * mu_); \
                asm volatile("" : "+v"(acc[ai][bj][m][0]), "+v"(acc[ai][bj][m][1])); } } while (0)
        RL_GROUP(0, 21); RL_GROUP(1, 18); RL_GROUP(2, 15); RL_GROUP(3, 12); RL_GROUP(4, 9); RL_GROUP(5, 6); RL_GROUP(6, 3); RL_GROUP(7, 0);
#undef RL_GROUP
    }
#undef RL_LD16
#undef RL_LD8
    __device__ __forceinline__ void operator()(const f32x4 (&acc)[2][2][4][2], const Unit& u, int wr, int wc, int fr, int fq, const LAS unsigned char* lds, int par) const {
        const int row0 = u.pm * BM + wr * 64 + fr, col0 = u.pn * BM + wc * 32 + 8 * fq;
        float psum[8], psq[8];
#pragma unroll
        for (int i = 0; i < 8; ++i) { const int ai = i >> 2, m = i & 3; const int row = row0 + ai * HALF + m * 16; unsigned char* hp = (unsigned char*)(YHo ? YHo : YH);
            f32x4 vs = {0.f, 0.f, 0.f, 0.f}, vq = {0.f, 0.f, 0.f, 0.f}; u32x4 lq;
#pragma unroll
            for (int bj = 0; bj < 2; ++bj) { const f32x4 y0 = acc[ai][bj][m][0] * s, y1 = acc[ai][bj][m][1] * s;
                vs += y0 + y1; vq = y0 * y0 + vq; vq = y1 * y1 + vq;
                u32x4 h; h.x = cvt_pk_bf16(y0[0], y0[1]); h.y = cvt_pk_bf16(y0[2], y0[3]); h.z = cvt_pk_bf16(y1[0], y1[1]); h.w = cvt_pk_bf16(y1[2], y1[3]);
                const f32x4 r0 = y0 * LO_SCALE + (f32x4){bf_lo(h.x), bf_hi(h.x), bf_lo(h.y), bf_hi(h.y)} * (-LO_SCALE), r1 = y1 * LO_SCALE + (f32x4){bf_lo(h.z), bf_hi(h.z), bf_lo(h.w), bf_hi(h.w)} * (-LO_SCALE);
                u32x2 l; l.x = lo8_pack4s(r0[0], r0[1], r0[2], r0[3]); l.y = lo8_pack4s(r1[0], r1[1], r1[2], r1[3]);
                *(u32x4*)(hp + atile_byte(row, col0 + bj * HALF, ldc)) = h; if (bj == 0) { lq.x = l.x; lq.y = l.y; } else { lq.z = l.x; lq.w = l.y; } }
            float ps = (vs[0] + vs[1]) + (vs[2] + vs[3]), pss = (vq[0] + vq[1]) + (vq[2] + vq[3]);
            *(u32x4*)((YLo ? YLo : YL) + lo_rec(u.pm, u.pn, wr, wc, fr, fq) + i * 1024) = lq;
            ps += __shfl_xor(ps, 16); ps += __shfl_xor(ps, 32); pss += __shfl_xor(pss, 16); pss += __shfl_xor(pss, 32);
            psum[i] = ps; psq[i] = pss;
        }
#pragma unroll
        for (int ai = 0; ai < 2; ++ai)
#pragma unroll
            for (int k = 0; k < 2; ++k) { const int m = 2 * k + (fq >> 1);
                const float sv = (fq >> 1) ? psum[ai * 4 + 2 * k + 1] : psum[ai * 4 + 2 * k], qv = (fq >> 1) ? psq[ai * 4 + 2 * k + 1] : psq[ai * 4 + 2 * k];
                __hip_atomic_fetch_add(stats_new + 2 * (size_t)(row0 + ai * HALF + m * 16) + (fq & 1), (fq & 1) ? qv : sv, __ATOMIC_RELAXED, __HIP_MEMORY_SCOPE_AGENT); }
    }
};
struct EpiNull {
    static constexpr bool PERM = true;
    float* Y; bf16_t* DUM;
    __device__ __forceinline__ void prefetch(LAS unsigned char*, int, const Unit&, int, int) const {}
    __device__ __forceinline__ void init(f32x4 (&acc)[2][2][4][2], const Unit& u, int wr, int wc, int fr, int fq) const {
#if PROBE_RESK == 3
        const int row0 = u.pm * BM + wr * 64 + fr, col0 = u.pn * BM + wc * 32 + 8 * fq; const float* yb = Y + (size_t)row0 * DM + col0;
#pragma unroll
        for (int ai = 0; ai < 2; ++ai)
#pragma unroll
            for (int m = 0; m < 4; ++m)
#pragma unroll
                for (int bj = 0; bj < 2; ++bj)
#pragma unroll
                    for (int n = 0; n < 2; ++n) acc[ai][bj][m][n] = *(const f32x4*)(yb + (size_t)(ai * HALF + m * 16) * DM + bj * HALF + 4 * n) * 0.f;
#else
#pragma unroll
        for (int a = 0; a < 2; ++a)
#pragma unroll
            for (int b = 0; b < 2; ++b)
#pragma unroll
                for (int m = 0; m < 4; ++m)
#pragma unroll
                    for (int n = 0; n < 2; ++n) acc[a][b][m][n] = (f32x4){0.f, 0.f, 0.f, 0.f};
#endif
    }
    __device__ __forceinline__ void operator()(const f32x4 (&acc)[2][2][4][2], const Unit& u, int wr, int wc, int fr, int fq, const LAS unsigned char* lds, int par) const {
        float t = 0.f;
#pragma unroll
        for (int a = 0; a < 2; ++a)
#pragma unroll
            for (int b = 0; b < 2; ++b)
#pragma unroll
                for (int m = 0; m < 4; ++m)
#pragma unroll
                    for (int n = 0; n < 2; ++n) t += (acc[a][b][m][n][0] + acc[a][b][m][n][1]) + (acc[a][b][m][n][2] + acc[a][b][m][n][3]);
        if (t == 1.2345e38f) Y[u.pm + wr + wc + fr + fq] = t;
#if PROBE_RESK == 2
        const int row0 = u.pm * BM + wr * 64 + fr, col0 = u.pn * BM + wc * 32 + 8 * fq;
#pragma unroll
        for (int i = 0; i < 8; ++i) { bf16_t* browp = DUM + (size_t)(row0 + (i >> 2) * HALF + (i & 3) * 16) * DM + col0;
#pragma unroll
            for (int bj = 0; bj < 2; ++bj) { const f32x4 v0 = acc[i >> 2][bj][i & 3][0], v1 = acc[i >> 2][bj][i & 3][1];
                u32x4 w; w.x = cvt_pk_bf16(v0[0], v0[1]); w.y = cvt_pk_bf16(v0[2], v0[3]); w.z = cvt_pk_bf16(v1[0], v1[1]); w.w = cvt_pk_bf16(v1[2], v1[3]);
                *(u32x4*)(browp + bj * HALF) = w; } }
#endif
    }
};
template <class Epi, class BS, class ORD>
__device__ __forceinline__ void gemm_phase(LAS unsigned char* lds, const Gemm g, const BS B, const ORD& S, const Epi& E, int tid_in) {
    int tid = tid_in; asm volatile("" : "+v"(tid));
    const int wid = __builtin_amdgcn_readfirstlane(tid >> 6), lane = tid & 63, wr = wid >> 2, wc = wid & 3, fr = lane & 15, fq = lane >> 4;
    const int K = g.K, nt = K / BK, lda = g.lda;
    unsigned voffA[2], voffB[2];
#pragma unroll
    for (int i = 0; i < 2; ++i) { int R, C; stage_rc(tid * 16 + i * 8192, R, C); const int Rb = Epi::PERM ? ((R & ~31) + perm32(R & 31)) : R;
        voffA[i] = g.tiled ? (unsigned)(tid * 16 + i * 8192) : (unsigned)(R * lda + C) * 2u; voffB[i] = (unsigned)(tid * 16 + i * 8192); (void)Rb; }
    const size_t kstep = g.tiled ? (size_t)32768 : (size_t)(BK * 2), kstepB = 32768;
    const size_t hstepA = g.tiled ? (size_t)16384 : (size_t)HALF * lda * 2;
    const size_t tstepA = g.tiled ? (size_t)(lda >> 6) * 32768 : 2 * hstepA;
    const unsigned ldsw = (unsigned)wid * 1024u;
    const int aoff = lds_byte(wr * 64 + fr, fq * 8), boff = lds_byte(wc * 32 + fr, fq * 8);
#define PG8_SA(b, h) (((b) * 2 + (h)) * HTB)
#define PG8_SB(b, h) ((4 + (b) * 2 + (h)) * HTB)
#define PG8_STAGE(bufoff, gbase, voff) do { _Pragma("unroll") for (int _i = 0; _i < 2; ++_i) \
        __builtin_amdgcn_global_load_lds((const unsigned*)((const char*)(gbase) + (voff)[_i]), (LAS unsigned*)(lds + (bufoff) + ldsw + _i * 8192), 16, 0, 0); } while (0)
#define PG8_LDA(dst, b, h) do { _Pragma("unroll") for (int m = 0; m < 4; ++m) _Pragma("unroll") for (int k = 0; k < 2; ++k) dst[m][k] = *(const LAS bf16x8*)(lds + PG8_SA(b, h) + aoff + m * 2048 + k * 1024); } while (0)
#define PG8_LDB(dst, b, h) do { _Pragma("unroll") for (int n = 0; n < 2; ++n) _Pragma("unroll") for (int k = 0; k < 2; ++k) dst[n][k] = *(const LAS bf16x8*)(lds + PG8_SB(b, h) + boff + n * 2048 + k * 1024); } while (0)
#define PG8_MMA(ai, bj, At, Bt) do { __builtin_amdgcn_s_setprio(1); _Pragma("unroll") for (int m = 0; m < 4; ++m) _Pragma("unroll") for (int n = 0; n < 2; ++n) _Pragma("unroll") for (int k = 0; k < 2; ++k) \
        acc[ai][bj][m][n] = __builtin_amdgcn_mfma_f32_16x16x32_bf16(Bt[n][k], At[m][k], acc[ai][bj][m][n], 0, 0, 0); __builtin_amdgcn_s_setprio(0); } while (0)
#define PG8_WAIT_V(n) asm volatile("s_waitcnt vmcnt(" #n ")" ::: "memory")
#define PG8_WAIT_L(n) asm volatile("s_waitcnt lgkmcnt(" #n ")" ::: "memory")
#define PG8_BAR __builtin_amdgcn_s_barrier()
#define PG8_SCHED __builtin_amdgcn_sched_barrier(0)
    Unit cur, nxt; int ui = 0;
    if (!S.next(0, cur)) return;
    f32x4 acc[2][2][4][2];
    E.init(acc, cur, wr, wc, fr, fq);
    E.prefetch(lds, 0, cur, wid, lane);
    bf16x8 At[4][2], B0[2][2], B1[2][2];
    const char* cA = (const char*)g.A + (size_t)cur.pm * tstepA; const char* cB0 = B.half(cur, 0); const char* cB1 = B.half(cur, 1);
    PG8_STAGE(PG8_SB(0, 0), cB0, voffB); PG8_STAGE(PG8_SB(0, 1), cB1, voffB); PG8_STAGE(PG8_SA(0, 0), cA, voffA); PG8_STAGE(PG8_SA(0, 1), cA + hstepA, voffA);
    if (wr == 1) PG8_BAR;
    PG8_WAIT_V(2); PG8_BAR;
    PG8_STAGE(PG8_SB(1, 0), cB0 + kstepB, voffB); PG8_STAGE(PG8_SA(1, 0), cA + kstep, voffA); PG8_STAGE(PG8_SB(1, 1), cB1 + kstepB, voffB);
    PG8_WAIT_V(6); PG8_BAR;
    for (;;) {
        const bool has_next = S.next(ui + 1, nxt);
        const char* nA = has_next ? (const char*)g.A + (size_t)nxt.pm * tstepA : cA;
        const char* nB0 = has_next ? B.half(nxt, 0) : cB0; const char* nB1 = has_next ? B.half(nxt, 1) : cB1;
        for (int t = 0; t < nt; t += 2) {
            const bool last = (t == nt - 2);
            const char* a1 = cA + (size_t)(t + 1) * kstep;
            const char* a2 = last ? nA : cA + (size_t)(t + 2) * kstep;
            const char* b20 = last ? nB0 : cB0 + (size_t)(t + 2) * kstepB; const char* b21 = last ? nB1 : cB1 + (size_t)(t + 2) * kstepB;
            const char* a3 = a2 + kstep; const char* b30 = b20 + kstepB; const char* b31 = b21 + kstepB;
            PG8_LDB(B0, 0, 0); PG8_LDB(B1, 0, 1); PG8_SCHED; PG8_LDA(At, 0, 0); PG8_STAGE(PG8_SA(1, 1), a1 + hstepA, voffA);
            PG8_WAIT_V(8); PG8_WAIT_L(0); PG8_BAR; PG8_MMA(0, 0, At, B0); PG8_MMA(0, 1, At, B1); PG8_BAR; PG8_SCHED;
            PG8_LDA(At, 0, 1); PG8_STAGE(PG8_SB(0, 0), b20, voffB); PG8_STAGE(PG8_SB(0, 1), b21, voffB); PG8_STAGE(PG8_SA(0, 0), a2, voffA);
            PG8_WAIT_V(8); PG8_WAIT_L(0); PG8_BAR; PG8_MMA(1, 0, At, B0); PG8_MMA(1, 1, At, B1); PG8_BAR; PG8_SCHED;
            PG8_LDB(B0, 1, 0); PG8_LDB(B1, 1, 1); PG8_SCHED; PG8_LDA(At, 1, 0); PG8_STAGE(PG8_SA(0, 1), a2 + hstepA, voffA);
            PG8_WAIT_V(8); PG8_WAIT_L(0); PG8_BAR; PG8_MMA(0, 0, At, B0); PG8_MMA(0, 1, At, B1); PG8_BAR; PG8_SCHED;
            PG8_LDA(At, 1, 1); PG8_STAGE(PG8_SB(1, 0), b30, voffB); PG8_STAGE(PG8_SB(1, 1), b31, voffB); PG8_STAGE(PG8_SA(1, 0), a3, voffA);
            PG8_WAIT_V(8); PG8_WAIT_L(0); PG8_BAR; PG8_MMA(1, 0, At, B0); PG8_MMA(1, 1, At, B1); PG8_BAR; PG8_SCHED;
        }
        if (wr == 0) PG8_BAR;
        E(acc, cur, wr, wc, fr, fq, lds, ui & 1);
        if (!has_next) break;
        E.init(acc, nxt, wr, wc, fr, fq);
        E.prefetch(lds, (ui + 1) & 1, nxt, wid, lane);
        cur = nxt; cA = nA; cB0 = nB0; cB1 = nB1; ++ui;
        if (wr == 1) PG8_BAR;
    }
    PG8_WAIT_V(0);
    PG8_BAR;
#undef PG8_SA
#undef PG8_SB
#undef PG8_STAGE
#undef PG8_LDA
#undef PG8_LDB
#undef PG8_MMA
#undef PG8_WAIT_V
#undef PG8_WAIT_L
#undef PG8_BAR
#undef PG8_SCHED
}
}

constexpr size_t MiB = 1u << 20;
constexpr size_t WS_CTL = 0, CTL_ZERO_BYTES = 6 * MiB;
constexpr size_t WS_STATS = 1 * MiB;
constexpr size_t WS_C1 = 4 * MiB + 512 * 1024, WS_C0 = 5 * MiB + 256 * 1024;
constexpr int CSTRIDE = 2 * DFF;
static_assert(WS_STATS + (size_t)12 * MTOK * 2 * 4 <= WS_C1 && WS_C1 + (size_t)12 * CSTRIDE * 4 <= WS_C0 && WS_C0 + (size_t)12 * CSTRIDE * 4 <= CTL_ZERO_BYTES, "zeroed region");
constexpr size_t SZ_WGU1 = (size_t)2 * DFF * DM * 2, SZ_WD1 = (size_t)DM * DFF * 2;
constexpr size_t SZ_NAQKV1 = (size_t)3 * DM * DM * 2, SZ_NAO1 = (size_t)DM * DM * 2;
constexpr size_t SZ_DQKV1 = (size_t)9216 * DM * 2, SZ_DO1 = (size_t)DM * 1024 * 2;
constexpr size_t WS_WGU = 6 * MiB;
constexpr size_t WS_WD = WS_WGU + 8 * SZ_WGU1;
constexpr size_t WS_NAQKV = WS_WD + 8 * SZ_WD1;
constexpr size_t WS_NAO = WS_NAQKV + 2 * SZ_NAQKV1;
constexpr size_t WS_DQKV = WS_NAO + 2 * SZ_NAO1;
constexpr size_t WS_DO = WS_DQKV + 2 * SZ_DQKV1;
constexpr size_t WS_XB = WS_DO + 2 * SZ_DO1;
constexpr size_t WS_BIG = WS_XB + (size_t)MTOK * DM * 2;
constexpr size_t SZ_BIG = (size_t)MTOK * 9216 * 2;
constexpr size_t WS_LSE = WS_BIG + SZ_BIG;
constexpr size_t WS_YLO = WS_LSE + (size_t)MTOK * 24 * 4;
constexpr size_t WS_END = WS_YLO + (size_t)MTOK * DM * 2;
static_assert((size_t)MTOK * DFF * 2 <= SZ_BIG, "big buffer");
constexpr int CW_GRP = 8192;
constexpr int CW_BAR = 4096;

constexpr int RING_BYTES = 131072;
constexpr int CTLZ_OFF = 147456 + 2048;
constexpr int MISC_OFF = CTLZ_OFF + 320;
constexpr int LDS_BYTES = 150528;
constexpr int NWAVES = 8;

#define RLX_AGENT __ATOMIC_RELAXED, __HIP_MEMORY_SCOPE_AGENT
#define LDS_WAIT() asm volatile("s_waitcnt lgkmcnt(0)" ::: "memory")

#define XB_TMO      128
#define XB_XCNT(j)  (256  + 64 * (j))
#define XB_XSUB(j)  (1280 + 64 * (j))
#define XB_XGEN(j)  (2304 + 64 * (j))
#define XB_TOP      3328
#define XB_TOPGEN   3392
#define XCD_BAR_WORDS 3456
#define XB_SPIN_CAP (1u << 20)

__device__ __forceinline__ unsigned xb_ld(unsigned* p)              { return __hip_atomic_load(p, __ATOMIC_RELAXED, __HIP_MEMORY_SCOPE_AGENT); }
__device__ __forceinline__ unsigned xb_add(unsigned* p, unsigned v) { return __hip_atomic_fetch_add(p, v, __ATOMIC_RELAXED, __HIP_MEMORY_SCOPE_AGENT); }
__device__ __forceinline__ unsigned xb_xcc_id() { return (unsigned)__builtin_amdgcn_s_getreg((3 << 11) | 20) & 0xFu; }
#define XB_SPIN(cond, bar) do { unsigned _sp = 0; while (cond) { __builtin_amdgcn_s_sleep(1); \
    if ((++_sp & 255u) == 0u) { if (xb_ld(&(bar)[XB_TMO])) break; if (_sp > XB_SPIN_CAP) { atomicAdd(&(bar)[XB_TMO], 1u); break; } } } } while (0)

__device__ __forceinline__ void xcd_barrier_post(unsigned* bar) {
    const unsigned x = xb_xcc_id();
    if (threadIdx.x == 0) (void)xb_add(&bar[XB_XCNT(x)], 1u);
}
__device__ __forceinline__ void xcd_barrier_complete(unsigned* bar, unsigned x, unsigned& nloc, unsigned& nx) {
    const unsigned G = gridDim.x * gridDim.y * gridDim.z;
    unsigned sum, cnt, mine, sp = 0u;
    for (;;) {
        sum = 0u; cnt = 0u; mine = 0u;
#pragma unroll
        for (unsigned j = 0; j < 16; ++j) { const unsigned c = xb_ld(&bar[XB_XCNT(j)]); sum += c; cnt += (c > 0u) ? 1u : 0u; mine = (j == x) ? c : mine; }
        if (sum == G) break;
        __builtin_amdgcn_s_sleep(1);
        if ((++sp & 255u) == 0u) { if (xb_ld(&bar[XB_TMO])) break; if (sp > XB_SPIN_CAP) { atomicAdd(&bar[XB_TMO], 1u); break; } }
    }
    nloc = mine > 0u ? mine : 1u; nx = cnt > 0u ? cnt : 1u;
}
__device__ __forceinline__ void xcd_barrier(unsigned* bar, volatile LAS unsigned* st, bool leader) {
    asm volatile("s_waitcnt vmcnt(0)" ::: "memory");
    __syncthreads();
    if (leader) {
        const unsigned x = xb_xcc_id();
        __builtin_amdgcn_s_waitcnt(0);
        unsigned nloc = st[0], nx = st[1];
        if (nloc == 0u) { xcd_barrier_complete(bar, x, nloc, nx); st[0] = nloc; st[1] = nx; }
        const unsigned old = xb_add(&bar[XB_XSUB(x)], 1u);
        const unsigned gen = old / nloc;
        if (old + 1u == (gen + 1u) * nloc) {
            __builtin_amdgcn_fence(__ATOMIC_RELEASE, "agent");
            asm volatile("s_waitcnt vmcnt(0)" ::: "memory");
            const unsigned og = xb_add(&bar[XB_TOP], 1u);
            const unsigned tg = og / nx;
            if (og + 1u == (tg + 1u) * nx) xb_add(&bar[XB_TOPGEN], 1u);
            else XB_SPIN(xb_ld(&bar[XB_TOPGEN]) == tg, bar);
            __builtin_amdgcn_fence(__ATOMIC_ACQUIRE, "agent");
            xb_add(&bar[XB_XGEN(x)], 1u);
            asm volatile("s_waitcnt vmcnt(0)" ::: "memory");
        } else {
            XB_SPIN(xb_ld(&bar[XB_XGEN(x)]) == gen, bar);
            __builtin_amdgcn_fence(__ATOMIC_ACQUIRE, "agent");
            asm volatile("s_waitcnt vmcnt(0)" ::: "memory");
        }
    }
    __syncthreads();
}

__device__ __forceinline__ float wave_sum(float v) {
#pragma unroll
    for (int o = 1; o < 64; o <<= 1) v += __shfl_xor(v, o);
    return v;
}
__device__ __forceinline__ void transpose_item(const float* W, int K, int N, bf16_t* WT, int drow0, int k0, int n0, LAS float* scr, int lane, const float* gvec, const float* bvec, float* c1, float* c0, float wscale = 1.0f) {
#pragma unroll 8
    for (int i = 0; i < 32; ++i) { const int kk = 2 * i + (lane >> 5); scr[kk * 33 + (lane & 31)] = W[(size_t)(k0 + kk) * N + n0 + (lane & 31)]; }
    LDS_WAIT(); asm volatile("" ::: "memory");
    const int c = lane & 7;
    float gk[8], bk[8];
#pragma unroll
    for (int i = 0; i < 8; ++i) { gk[i] = (gvec ? gvec[k0 + 8 * c + i] : 1.f) * wscale; bk[i] = (gvec ? bvec[k0 + 8 * c + i] : 0.f) * wscale; }
    float q1[4], q0[4];
#pragma unroll
    for (int j = 0; j < 4; ++j) { const int n = (lane >> 3) + 8 * j; const LAS float* sp = scr + (8 * c) * 33 + n;
        float w[8]; float p0 = 0.f;
#pragma unroll
        for (int i = 0; i < 8; ++i) { const float x = sp[i * 33]; w[i] = x * gk[i]; p0 += x * bk[i]; }
        u32x4 o; o.x = cvt_pk_bf16(w[0], w[1]); o.y = cvt_pk_bf16(w[2], w[3]); o.z = cvt_pk_bf16(w[4], w[5]); o.w = cvt_pk_bf16(w[6], w[7]);
        *(GAS u32x4*)((GAS unsigned char*)WT + pg8::wtile_byte(drow0 + n, k0 + 8 * c, K)) = o;
        q1[j] = ((bf_lo(o.x) + bf_hi(o.x)) + (bf_lo(o.y) + bf_hi(o.y))) + ((bf_lo(o.z) + bf_hi(o.z)) + (bf_lo(o.w) + bf_hi(o.w))); q0[j] = p0;
    }
    if (gvec) {
#pragma unroll
        for (int j = 0; j < 4; ++j)
#pragma unroll
            for (int m = 1; m < 8; m <<= 1) { q1[j] += __shfl_xor(q1[j], m); q0[j] += __shfl_xor(q0[j], m); }
        const int jj = c & 3;
        const float v1 = jj == 0 ? q1[0] : jj == 1 ? q1[1] : jj == 2 ? q1[2] : q1[3], v0 = jj == 0 ? q0[0] : jj == 1 ? q0[1] : jj == 2 ? q0[2] : q0[3];
        float* dst = (c < 4 ? c1 : c0) + drow0 + (lane >> 3) + 8 * jj;
        __hip_atomic_fetch_add(dst, c < 4 ? v1 : v0, __ATOMIC_RELAXED, __HIP_MEMORY_SCOPE_AGENT);
    }
    LDS_WAIT(); asm volatile("" ::: "memory");
}

struct Args { const float* in[13]; float* out; unsigned char* ws; };

__device__ const unsigned char T5_BUCKET[3][65] = {
 {0, 1, 2, 3, 4, 5, 6, 7, 8, 8, 8, 8, 8, 8, 8, 9, 9, 9, 9, 9, 9, 9, 9, 9, 9, 9, 9, 10, 10, 10, 10, 10, 10, 10, 10, 10, 10, 10, 10, 10, 10, 10, 10, 10, 10, 10, 10, 10, 10, 10, 11, 11, 11, 11, 11, 11, 11, 11, 11, 11, 11, 11, 11, 11, 11},
 {0, 4, 8, 8, 9, 9, 9, 10, 10, 10, 10, 10, 10, 11, 11, 11, 11, 11, 11, 11, 11, 11, 11, 12, 12, 12, 12, 12, 12, 12, 12, 12, 12, 12, 12, 12, 12, 12, 12, 12, 12, 12, 13, 13, 13, 13, 13, 13, 13, 13, 13, 13, 13, 13, 13, 13, 13, 13, 13, 13, 13, 13, 13, 13, 13},
 {0, 9, 10, 10, 11, 11, 12, 12, 12, 12, 12, 13, 13, 13, 13, 13, 13, 13, 13, 13, 14, 14, 14, 14, 14, 14, 14, 14, 14, 14, 14, 14, 14, 14, 14, 15, 15, 15, 15, 15, 15, 15, 15, 15, 15, 15, 15, 15, 15, 15, 15, 15, 15, 15, 15, 15, 15, 15, 15, 15, 15, 15, 15, 15, 15}};

__device__ __forceinline__ bf16x8 pack8(const f32x4 a, const f32x4 b) {
    u32x4 w; w.x = cvt_pk_bf16(a[0], a[1]); w.y = cvt_pk_bf16(a[2], a[3]); w.z = cvt_pk_bf16(b[0], b[1]); w.w = cvt_pk_bf16(b[2], b[3]);
    return __builtin_bit_cast(bf16x8, w);
}
__device__ __forceinline__ bf16x8 join8(const u32x2 a, const u32x2 b) { u32x4 w; w.x = a.x; w.y = a.y; w.z = b.x; w.w = b.y; return __builtin_bit_cast(bf16x8, w); }

typedef short v4i16_t __attribute__((ext_vector_type(4)));
__device__ __forceinline__ u32x2 tr_read(const LAS unsigned char* p) { return __builtin_bit_cast(u32x2, __builtin_amdgcn_ds_read_tr16_b64_v4i16((LAS v4i16_t*)p)); }
__device__ __forceinline__ int swz_f(int r) { return ((r & 3) << 2) | ((r >> 2) & 3); }
__device__ __forceinline__ void glds16(const GAS void* gsrc, unsigned lds_dst) { unsigned keep;
    asm volatile("s_mov_b32 %0, m0\n\ts_mov_b32 m0, %2\n\ts_nop 0\n\tglobal_load_lds_dwordx4 %1, off\n\ts_mov_b32 m0, %0" : "=&s"(keep) : "v"(gsrc), "s"(lds_dst) : "memory"); }
__device__ __forceinline__ unsigned lds_addr(const LAS unsigned char* p) { return (unsigned)__builtin_amdgcn_readfirstlane((int)(unsigned)(size_t)p); }

struct NaU { int tok0, rows, h, r0, ks, ke; };
__device__ __forceinline__ NaU na_decode(int id) {
    NaU u; int band;
    if (id < 1024) { const int img = id >> 7, rem = id & 127; u.h = rem >> 3; band = rem & 7; u.rows = 32; u.tok0 = img * 2048; }
    else { const int i2 = id - 1024, img = i2 >> 8, rem = i2 & 255; u.h = rem >> 4; band = rem & 15; u.rows = 64; u.tok0 = PROMPT_TOK + img * 4096; }
    u.r0 = 4 * band; u.ks = imin(imax(u.r0 - 4, 0), u.rows - 8); u.ke = imin(imax(u.r0 - 1, 0), u.rows - 8) + 7; return u;
}
__device__ __forceinline__ void na_issue(LAS unsigned char* lds, const GAS bf16_t* QKV, int tok0, int h, int kr, int slot, int wave, int lane) {
    const int srow = lane >> 4, spos = lane & 15;
    const int coloff = (wave < 4 ? 2048 : 4096) + h * 128;
#pragma unroll
    for (int j = 0; j < 4; ++j) {
        const int col = 16 * (wave & 3) + 4 * j + srow;
        const GAS bf16_t* src = QKV + (size_t)(tok0 + kr * 64 + col) * 6144 + coloff + 8 * (spos ^ ((srow << 2) | j));
        glds16(src, lds_addr(lds + slot * 32768 + (16 * wave + 4 * j) * 256));
    }
}
__device__ __forceinline__ void na_tile_stage(const LAS unsigned char* slot, const LAS float* rpa, int qj, const bf16x8 (&qf)[4], f32x4 (&o)[8], float& m, float& l, int q, int g, int lane) {
    const int kb_lo = qj == 0 ? 0 : qj - 1;
    const bool three = (qj == 1) || (qj == 2);
    const int fk = swz_f(q);
    const int cq = 16 * qj + q, cs = imin(imax(cq - 8, 0), 48);
    bf16x8 kf[3][4]; float bias[3][4];
    const LAS unsigned char* kp = slot + (16 * kb_lo + q) * 256;
#pragma unroll
    for (int kbi = 0; kbi < 3; ++kbi)
#pragma unroll
        for (int kk = 0; kk < 4; ++kk) kf[kbi][kk] = *(const LAS bf16x8*)(kp + (kbi < 2 || three ? kbi : 0) * 4096 + 16 * ((4 * kk + g) ^ fk));
#pragma unroll
    for (int kbi = 0; kbi < 3; ++kbi)
#pragma unroll
        for (int e = 0; e < 4; ++e) bias[kbi][e] = rpa[imin(imax(16 * (kb_lo + kbi) + 4 * g + e - cq + 15, 0), 30)];
    __builtin_amdgcn_sched_barrier(0);
    f32x4 s[3];
#pragma unroll
    for (int kbi = 0; kbi < 3; ++kbi) { f32x4 acc = (f32x4){bias[kbi][0], bias[kbi][1], bias[kbi][2], bias[kbi][3]};
#pragma unroll
        for (int kk = 0; kk < 4; ++kk) acc = __builtin_amdgcn_mfma_f32_16x16x32_bf16(kf[kbi][kk], qf[kk], acc, 0, 0, 0);
        s[kbi] = acc; }
    const int qq = q >> 2, pp = lane & 3, fv = (qq << 2) | g;
    const LAS unsigned char* vx = slot + 16384 + (16 * kb_lo + 4 * g + qq) * 256 + 8 * (pp & 1);
    u32x2 vfx[8], vfy[8];
#pragma unroll
    for (int dt = 0; dt < 8; ++dt) { const int co = 16 * ((2 * dt + (pp >> 1)) ^ fv); vfx[dt] = tr_read(vx + co); vfy[dt] = tr_read(vx + 16 * 256 + co); }
    __builtin_amdgcn_sched_barrier(0);
    float mloc = -1e30f;
#pragma unroll
    for (int kbi = 0; kbi < 3; ++kbi)
#pragma unroll
        for (int e = 0; e < 4; ++e) {
            const int ck = 16 * (kb_lo + kbi) + 4 * g + e;
            const bool valid = (kbi < 2 || three) && (ck >= cs) && (ck < cs + 16);
            const float v = valid ? s[kbi][e] : -1e30f;
            s[kbi][e] = v; mloc = fmaxf(mloc, v);
        }
    mloc = fmaxf(mloc, __shfl_xor(mloc, 16)); mloc = fmaxf(mloc, __shfl_xor(mloc, 32));
    const float mn = fmaxf(m, mloc), alpha = __builtin_amdgcn_exp2f(m - mn);
    m = mn;
    float ps = 0.f;
#pragma unroll
    for (int kbi = 0; kbi < 3; ++kbi)
#pragma unroll
        for (int e = 0; e < 4; ++e) { const float p = __builtin_amdgcn_exp2f(s[kbi][e] - mn); s[kbi][e] = p; ps += p; }
    l = l * alpha + ps;
#pragma unroll
    for (int dt = 0; dt < 8; ++dt) o[dt] = o[dt] * alpha;
    const bf16x8 pf = pack8(s[0], s[1]);
    const bf16x8 pf2 = pack8(s[2], (f32x4){0.f, 0.f, 0.f, 0.f});
    __builtin_amdgcn_sched_barrier(0);
#pragma unroll
    for (int dt = 0; dt < 8; ++dt) o[dt] = __builtin_amdgcn_mfma_f32_16x16x32_bf16(join8(vfx[dt], vfy[dt]), pf, o[dt], 0, 0, 0);
    if (three) {
#pragma unroll
        for (int dt = 0; dt < 8; ++dt) { const int co = 16 * ((2 * dt + (pp >> 1)) ^ fv); vfx[dt] = tr_read(vx + 32 * 256 + co); }
        __builtin_amdgcn_sched_barrier(0);
#pragma unroll
        for (int dt = 0; dt < 8; ++dt) o[dt] = __builtin_amdgcn_mfma_f32_16x16x32_bf16(join8(vfx[dt], vfx[dt]), pf2, o[dt], 0, 0, 0);
    }
}
__device__ __forceinline__ void na_phase(LAS unsigned char* lds, const GAS bf16_t* QKV, GAS bf16_t* O, int ldo, const float* rpb, int vcu, int G, int tid, int lane, int wave) {
    LAS float* rp = (LAS float*)(lds + 147456);
    const int q = lane & 15, g = lane >> 4;
    int idC = vcu; asm volatile("" : "+s"(idC));
    if (idC >= 2048) return;
    NaU uI = na_decode(idC); int idI = idC, krI = uI.ks; bool exI = false;
#define NA_ISSUE(slot_) do { na_issue(lds, QKV, uI.tok0, uI.h, krI, (slot_), wave, lane); \
        if (!exI) { if (krI < uI.ke) ++krI; else if (idI + G < 2048) { idI += G; uI = na_decode(idI); krI = uI.ks; } else exI = true; } } while (0)
    __syncthreads();
    NA_ISSUE(0); NA_ISSUE(1); NA_ISSUE(2);
    int gs = 0;
    for (;;) {
        const NaU u = na_decode(idC);
        const int r = u.r0 + (wave >> 1), rs_r = imin(imax(r - 4, 0), u.rows - 8), qj0 = 2 * (wave & 1);
        const GAS bf16_t* qrow = QKV + (size_t)(u.tok0 + r * 64 + 16 * qj0 + q) * 6144 + u.h * 128 + 8 * g;
        bf16x8 qf0[4], qf1[4];
#pragma unroll
        for (int kk = 0; kk < 4; ++kk) { qf0[kk] = *(const GAS bf16x8*)(qrow + 32 * kk); qf1[kk] = *(const GAS bf16x8*)(qrow + (size_t)16 * 6144 + 32 * kk); }
#pragma unroll
        for (int kk = 0; kk < 4; ++kk) asm volatile("" : "+v"(qf0[kk]), "+v"(qf1[kk]));
        asm volatile("s_barrier" ::: "memory");
        if (tid < 465) rp[tid] = rpb[u.h * 465 + tid] * LOG2E;
        f32x4 o0[8], o1[8];
#pragma unroll
        for (int dt = 0; dt < 8; ++dt) { o0[dt] = (f32x4){0.f, 0.f, 0.f, 0.f}; o1[dt] = (f32x4){0.f, 0.f, 0.f, 0.f}; }
        float m0 = -1e30f, m1 = -1e30f, l0 = 0.f, l1 = 0.f;
        for (int kr = u.ks; kr <= u.ke; ++kr) {
            asm volatile("s_waitcnt vmcnt(8) lgkmcnt(0)\n\ts_barrier" ::: "memory");
            NA_ISSUE((gs + 3) & 3);
            if (kr >= rs_r && kr < rs_r + 8) {
                const LAS unsigned char* slot = lds + (gs & 3) * 32768;
                const LAS float* rpa = rp + (kr - r + 7) * 31;
                na_tile_stage(slot, rpa, qj0, qf0, o0, m0, l0, q, g, lane);
                na_tile_stage(slot, rpa, qj0 + 1, qf1, o1, m1, l1, q, g, lane);
            }
            ++gs;
        }
        l0 += __shfl_xor(l0, 16); l0 += __shfl_xor(l0, 32); l1 += __shfl_xor(l1, 16); l1 += __shfl_xor(l1, 32);
        const float i0 = 1.0f / l0, i1 = 1.0f / l1;
        GAS bf16_t* orow = O + (size_t)(u.tok0 + r * 64 + 16 * qj0 + q) * ldo + u.h * 128 + 4 * g;
#pragma unroll
        for (int dt = 0; dt < 8; ++dt) { const f32x4 v0 = o0[dt] * i0, v1 = o1[dt] * i1; u32x2 w0, w1; w0.x = cvt_pk_bf16(v0[0], v0[1]); w0.y = cvt_pk_bf16(v0[2], v0[3]); w1.x = cvt_pk_bf16(v1[0], v1[1]); w1.y = cvt_pk_bf16(v1[2], v1[3]);
            *(GAS u32x2*)(orow + 16 * dt) = w0; *(GAS u32x2*)(orow + (size_t)16 * ldo + 16 * dt) = w1; }
        idC += G; if (idC >= 2048) break;
    }
#undef NA_ISSUE
    asm volatile("s_waitcnt vmcnt(0)" ::: "memory");
    __syncthreads();
}

struct DilU { int btok0, grp, sh, L, rho, l0b, h; };
__device__ __forceinline__ DilU dil_decode(int id) {
    DilU u; const int gh = id >> 8, pb = id & 255; u.grp = gh >> 3; u.h = gh & 7; u.sh = 2 * u.grp;
    int T, pp;
    if (pb < 128) { T = 2048; u.btok0 = (pb >> 4) * 2048; pp = (pb & 15) * 128; }
    else { T = 4096; u.btok0 = PROMPT_TOK + ((pb - 128) >> 5) * 4096; pp = ((pb - 128) & 31) * 128; }
    u.L = T >> u.sh; u.rho = pp / u.L; u.l0b = pp - u.rho * u.L; return u;
}
__device__ __forceinline__ void dil_stage(LAS unsigned char* tile, const GAS bf16_t* QKV, const DilU& u, int coloff, int wave, int lane) {
    const int srow = lane >> 4, spos = lane & 15;
#pragma unroll
    for (int i = 0; i < 8; ++i) {
        const int trow = 32 * wave + 4 * i + srow;
        const int lk = imin(imax(u.l0b - 64 + trow, 0), u.L - 1);
        glds16(QKV + (size_t)(u.btok0 + (lk << u.sh) + u.rho) * 9216 + u.grp * 3072 + u.h * 128 + coloff + 8 * (spos ^ swz_f(trow)), lds_addr(tile + (32 * wave + 4 * i) * 256));
    }
}
__device__ __forceinline__ void dil_bias(LAS float* bt, const float* relb, const DilU& u, int tid) {
    if (tid < 129) { const int rel = tid - 64, mag = rel < 0 ? -rel : rel; const int bucket = (rel > 0 ? 16 : 0) + T5_BUCKET[u.grp][mag];
        bt[tid] = relb[bucket * 24 + u.grp * 8 + u.h] * LOG2E; }
}
__device__ __forceinline__ void dil_phase(LAS unsigned char* lds, const GAS bf16_t* QKV, GAS bf16_t* O, int ldo, int gstride, GAS float* LSE, const float* relb, int vcu, int G, int tid, int lane, int wave) {
    LAS float* bt = (LAS float*)(lds + 147456);
    const int q = lane & 15, g = lane >> 4;
    int id = vcu; asm volatile("" : "+s"(id));
    if (id >= 6144) return;
    DilU u = dil_decode(id);
    __syncthreads();
    dil_bias(bt, relb, u, tid);
    dil_stage(lds, QKV, u, 1024, wave, lane);
#define DIL_QLOAD(dst_, uu_) do { const int tq_ = (uu_).btok0 + (((uu_).l0b + 16 * wave + q) << (uu_).sh) + (uu_).rho; const GAS bf16_t* qp_ = QKV + (size_t)tq_ * 9216 + (uu_).grp * 3072 + (uu_).h * 128 + 8 * g; \
        _Pragma("unroll") for (int kk = 0; kk < 4; ++kk) dst_[kk] = *(const GAS bf16x8*)(qp_ + 32 * kk); } while (0)
    bf16x8 qn[4]; DIL_QLOAD(qn, u);
    {
        volatile GAS float* lp = (volatile GAS float*)LSE + (size_t)(u.btok0 + ((u.l0b + 16 * wave + q) << u.sh) + u.rho) * 24 + u.grp * 8 + u.h;
#pragma unroll
        for (int i = 0; i < 8; ++i) *lp = 0.f;
    }
    for (;;) {
        const int l0 = u.l0b + 16 * wave;
        const int tq = u.btok0 + ((l0 + q) << u.sh) + u.rho;
        asm volatile("s_waitcnt vmcnt(8) lgkmcnt(0)\n\ts_barrier" ::: "memory");
        bf16x8 qf[4];
#pragma unroll
        for (int kk = 0; kk < 4; ++kk) { qf[kk] = qn[kk]; asm volatile("" : "+v"(qf[kk])); }
        dil_stage(lds + 65536, QKV, u, 2048, wave, lane);
        const int fk = swz_f(q);
        f32x4 s[10];
#pragma unroll
        for (int kb3 = 0; kb3 < 3; ++kb3) {
            bf16x8 kf[3][4];
#pragma unroll
            for (int j = 0; j < 3; ++j)
#pragma unroll
                for (int kk = 0; kk < 4; ++kk) kf[j][kk] = *(const LAS bf16x8*)(lds + (16 * wave + 16 * (3 * kb3 + j) + q) * 256 + 16 * ((4 * kk + g) ^ fk));
            __builtin_amdgcn_sched_barrier(0);
#pragma unroll
            for (int j = 0; j < 3; ++j) { f32x4 acc = (f32x4){0.f, 0.f, 0.f, 0.f};
#pragma unroll
                for (int kk = 0; kk < 4; ++kk) acc = __builtin_amdgcn_mfma_f32_16x16x32_bf16(kf[j][kk], qf[kk], acc, 0, 0, 0);
                s[3 * kb3 + j] = acc; }
            __builtin_amdgcn_sched_barrier(0);
        }
        s[9] = (f32x4){0.f, 0.f, 0.f, 0.f};
        float mx = -1e30f;
#pragma unroll
        for (int kb = 0; kb < 9; ++kb) {
            float bias[4];
#pragma unroll
            for (int e = 0; e < 4; ++e) bias[e] = bt[imin(imax(16 * kb + 4 * g + e - q, 0), 128)];
            asm volatile("" : "+v"(bias[0]), "+v"(bias[1]), "+v"(bias[2]), "+v"(bias[3]));
#pragma unroll
            for (int e = 0; e < 4; ++e) {
                const int rel = -64 + 16 * kb + 4 * g + e - q, lkey = l0 + q + rel;
                const bool valid = (rel >= -64) && (rel <= 64) && (lkey >= 0) && (lkey < u.L);
                const float v = valid ? s[kb][e] * QK_SCALE2 + bias[e] : -1e30f;
                s[kb][e] = v; mx = fmaxf(mx, v);
            }
        }
        mx = fmaxf(mx, __shfl_xor(mx, 16)); mx = fmaxf(mx, __shfl_xor(mx, 32));
        float sum = 0.f;
#pragma unroll
        for (int kb = 0; kb < 9; ++kb)
#pragma unroll
            for (int e = 0; e < 4; ++e) { const float p = __builtin_amdgcn_exp2f(s[kb][e] - mx); s[kb][e] = p; sum += p; }
        sum += __shfl_xor(sum, 16); sum += __shfl_xor(sum, 32);
        const float inv = 1.0f / sum;
        if (g == 0) LSE[(size_t)tq * 24 + u.grp * 8 + u.h] = mx + __builtin_amdgcn_logf(sum);
        asm volatile("s_barrier" ::: "memory");
        const int idn = id + G; const bool hn = idn < 6144;
        const DilU un = hn ? dil_decode(idn) : u;
        dil_bias(bt, relb, un, tid);
        dil_stage(lds, QKV, un, 1024, wave, lane);
        DIL_QLOAD(qn, un);
        asm volatile("s_waitcnt vmcnt(12)\n\ts_barrier" ::: "memory");
        f32x4 o[8];
#pragma unroll
        for (int dt = 0; dt < 8; ++dt) o[dt] = (f32x4){0.f, 0.f, 0.f, 0.f};
        const int qq = q >> 2, pp = lane & 3, fv = (qq << 2) | g;
        const LAS unsigned char* vlane = lds + 65536 + (16 * wave + 4 * g + qq) * 256 + 8 * (pp & 1);
#pragma unroll
        for (int c = 0; c < 5; ++c) {
            const bf16x8 pf = pack8(s[2 * c], s[2 * c + 1]);
            const LAS unsigned char* vx = vlane + (32 * c) * 256;
            const int yo = (c == 4) ? 0 : 16 * 256;
            u32x2 vfx[8], vfy[8];
#pragma unroll
            for (int dt = 0; dt < 8; ++dt) { const int co = 16 * ((2 * dt + (pp >> 1)) ^ fv); vfx[dt] = tr_read(vx + co); vfy[dt] = tr_read(vx + yo + co); }
            __builtin_amdgcn_sched_barrier(0);
#pragma unroll
            for (int dt = 0; dt < 8; ++dt) o[dt] = __builtin_amdgcn_mfma_f32_16x16x32_bf16(join8(vfx[dt], vfy[dt]), pf, o[dt], 0, 0, 0);
            __builtin_amdgcn_sched_barrier(0);
        }
        GAS bf16_t* orow = O + (size_t)tq * ldo + u.grp * gstride + u.h * 128;
#pragma unroll
        for (int dt = 0; dt < 8; ++dt) { const f32x4 v = o[dt] * inv; u32x2 w; w.x = cvt_pk_bf16(v[0], v[1]); w.y = cvt_pk_bf16(v[2], v[3]);
            *(GAS u32x2*)(orow + 16 * dt + 4 * g) = w; }
        if (!hn) break;
        u = un; id = idn;
    }
    asm volatile("s_waitcnt vmcnt(0)" ::: "memory");
    __syncthreads();
#undef DIL_QLOAD
}

__device__ __forceinline__ void group_sync(unsigned* bar, unsigned* cnt, unsigned target, bool leader) {
    asm volatile("s_waitcnt vmcnt(0)" ::: "memory");
    __syncthreads();
    if (leader) {
        __builtin_amdgcn_fence(__ATOMIC_RELEASE, "agent");
        asm volatile("s_waitcnt vmcnt(0)" ::: "memory");
        (void)xb_add(cnt, 1u);
        XB_SPIN(xb_ld(cnt) < target, bar);
        __builtin_amdgcn_fence(__ATOMIC_ACQUIRE, "agent");
        asm volatile("s_waitcnt vmcnt(0)" ::: "memory");
    }
    __syncthreads();
}

__global__ void __launch_bounds__(NWAVES * 64, 2) fwd(Args args) {
    extern __shared__ __attribute__((aligned(16))) unsigned char lds_raw[];
    LAS unsigned char* lds = (LAS unsigned char*)lds_raw;
    volatile LAS unsigned* MISC = (volatile LAS unsigned*)(lds + MISC_OFF);
    const int G = gridDim.x, bx = blockIdx.x;
    const int vcu = (G % 8 == 0) ? (bx % 8) * (G / 8) + bx / 8 : bx;
    const int NGW = G * NWAVES;
    const int wave_k = __builtin_amdgcn_readfirstlane((int)threadIdx.x >> 6);
    { const int t0 = threadIdx.x; for (int u = t0; u < (LDS_BYTES - CTLZ_OFF) / 4; u += NWAVES * 64) ((LAS unsigned*)(lds + CTLZ_OFF))[u] = 0u; }
    __syncthreads();
    xcd_barrier_post((unsigned*)(args.ws + WS_CTL) + CW_BAR);
    unsigned idle_ticks = 0u; (void)idle_ticks;
#define GRID_BAR() do { GAS unsigned* bg_ = (GAS unsigned*)(args.ws + WS_CTL) + CW_BAR; asm volatile("" : "+s"(bg_)); unsigned* b_ = (unsigned*)bg_; int w_ = wave_k; asm volatile("" : "+s"(w_)); \
    const bool ld_ = (w_ == 0) && (lane_id_fresh() == 0); const unsigned long long tb0_ = PROBE_IDLE ? __builtin_amdgcn_s_memrealtime() : 0ull; xcd_barrier(b_, MISC + 8, ld_); if (PROBE_IDLE) idle_ticks += (unsigned)(__builtin_amdgcn_s_memrealtime() - tb0_); } while (0)
    unsigned gs_round = 0u;
#define GROUP_SYNC() do { GAS unsigned* bg_ = (GAS unsigned*)(args.ws + WS_CTL) + CW_BAR; asm volatile("" : "+s"(bg_)); unsigned* b_ = (unsigned*)bg_; int w_ = wave_k; asm volatile("" : "+s"(w_)); \
    const bool ld_ = (w_ == 0) && (lane_id_fresh() == 0); gs_round += 1u; const unsigned long long tb0_ = PROBE_IDLE ? __builtin_amdgcn_s_memrealtime() : 0ull; \
    group_sync(b_, b_ + CW_GRP + 32 * (vcu / pg8::GS), gs_round * (unsigned)pg8::GS, ld_); if (PROBE_IDLE) idle_ticks += (unsigned)(__builtin_amdgcn_s_memrealtime() - tb0_); } while (0)
#define PHASE_LOCALS() const int lane = lane_id_fresh(); int wave = wave_k; asm volatile("" : "+s"(wave)); \
    const int tid = wave * 64 + lane; const int gw = vcu * NWAVES + wave; \
    GAS unsigned char* wsg_ = (GAS unsigned char*)args.ws; asm volatile("" : "+s"(wsg_)); unsigned char* ws = (unsigned char*)wsg_; GAS float* outg_ = (GAS float*)args.out; asm volatile("" : "+s"(outg_)); float* out = (float*)outg_; (void)tid; (void)gw; (void)out; \
    bf16_t* WGU = (bf16_t*)(ws + WS_WGU); bf16_t* WD = (bf16_t*)(ws + WS_WD); bf16_t* NAQKV = (bf16_t*)(ws + WS_NAQKV); bf16_t* NAO = (bf16_t*)(ws + WS_NAO); \
    bf16_t* DQKV = (bf16_t*)(ws + WS_DQKV); bf16_t* DOW = (bf16_t*)(ws + WS_DO); bf16_t* XB = (bf16_t*)(ws + WS_XB); bf16_t* BIG = (bf16_t*)(ws + WS_BIG); \
    float* LSE = (float*)(ws + WS_LSE); unsigned char* YLO = (unsigned char*)(ws + WS_YLO); (void)YLO; float* STATS = (float*)(ws + WS_STATS); float* C1 = (float*)(ws + WS_C1); float* C0 = (float*)(ws + WS_C0); (void)STATS; (void)C1; (void)C0; (void)WGU; (void)WD; (void)NAQKV; (void)NAO; (void)DQKV; (void)DOW; (void)XB; (void)BIG; (void)LSE;

    for (int rep = PROBE_P0 - 1; rep >= 0; --rep) {
        PHASE_LOCALS();
        if (rep) { C1 = (float*)(ws + WS_END); C0 = C1 + 12 * CSTRIDE; }
        LAS float* scr = (LAS float*)(lds + wave * 16384);
        constexpr int NFFN = 24 * 5632, NNAQ = 2 * 6144, NNAO = 2 * 2048, NDQ = 2 * 9216, NDO = 2 * 1024;
        constexpr int NITEMS = NFFN + NNAQ + NNAO + NDQ + NDO;
        for (int it = gw; it < NITEMS; it += NGW) {
            int r = it;
            if (r < NFFN) {
                const int m = r / 5632, rr = r - m * 5632, f = m / 3, kind = m - 3 * f;
                if (kind < 2) { const int kb = rr / 176, nb = rr - kb * 176, n0 = nb * 32;
                    const int slc = 3 * (f >> 1) + 2 * (f & 1);
                    transpose_item(args.in[4 + kind] + (size_t)f * DM * DFF, DM, DFF, WGU + (size_t)f * 2 * DFF * DM, (n0 >> 7) * 256 + (n0 & 127) + kind * 128, kb * 64, n0, scr, lane,
                                   slc ? args.in[2] + (size_t)(slc - 1) * DM : nullptr, args.in[3] + (size_t)(slc ? slc - 1 : 0) * DM, C1 + (size_t)slc * CSTRIDE, C0 + (size_t)slc * CSTRIDE, kind == 0 ? -LOG2E : 1.0f); }
                else { const int kb = rr / 64, nb = rr - kb * 64, n0 = nb * 32;
                    transpose_item(args.in[6] + (size_t)f * DFF * DM, DFF, DM, WD + (size_t)f * DM * DFF, n0, kb * 64, n0, scr, lane, nullptr, nullptr, nullptr, nullptr); }
                continue;
            }
            r -= NFFN;
            if (r < NNAQ) { const int j = r / 6144, rr = r - j * 6144, kb = rr / 192, nb = rr - kb * 192, n0 = nb * 32;
                transpose_item(args.in[7] + (size_t)j * DM * 6144, DM, 6144, NAQKV + (size_t)j * 6144 * DM, n0, kb * 64, n0, scr, lane, args.in[2] + (size_t)(6 * j) * DM, args.in[3] + (size_t)(6 * j) * DM, C1 + (size_t)(6 * j + 1) * CSTRIDE, C0 + (size_t)(6 * j + 1) * CSTRIDE, n0 < 2048 ? QK_SCALE2 : 1.0f); continue; }
            r -= NNAQ;
            if (r < NNAO) { const int j = r / 2048, rr = r - j * 2048, kb = rr / 64, nb = rr - kb * 64, n0 = nb * 32;
                transpose_item(args.in[8] + (size_t)j * DM * DM, DM, DM, NAO + (size_t)j * DM * DM, n0, kb * 64, n0, scr, lane, nullptr, nullptr, nullptr, nullptr); continue; }
            r -= NNAO;
            if (r < NDQ) { const int j = r / 9216, rr = r - j * 9216, kb = rr / 288, nb = rr - kb * 288, n0 = nb * 32;
                transpose_item(args.in[10] + (size_t)j * DM * 9216, DM, 9216, DQKV + (size_t)j * 9216 * DM, n0, kb * 64, n0, scr, lane, args.in[2] + (size_t)(6 * j + 3) * DM, args.in[3] + (size_t)(6 * j + 3) * DM, C1 + (size_t)(6 * j + 4) * CSTRIDE, C0 + (size_t)(6 * j + 4) * CSTRIDE); continue; }
            r -= NDQ;
            { const int j = r / 1024, rr = r - j * 1024, kb = rr / 64, nb = rr - kb * 64, n0 = nb * 32;
                transpose_item(args.in[11] + (size_t)j * 1024 * DM, 1024, DM, DOW + (size_t)j * DM * 1024, n0, kb * 64, n0, scr, lane, nullptr, nullptr, nullptr, nullptr); }
        }
        {
            const int wr = wave >> 2, wc = wave & 3, fr = lane & 15, fq = lane >> 4;
            for (int t = vcu; t < (MTOK / 256) * 8; t += G) {
                const int pm = t >> 3, pn = t & 7, row0 = pm * 256 + wr * 64 + fr, col0 = pn * 256 + wc * 32 + 8 * fq;
                const float* src = (row0 < PROMPT_TOK ? args.in[0] + (size_t)row0 * DM : args.in[1] + (size_t)(row0 - PROMPT_TOK) * DM) + col0;
                unsigned char* lrec = YLO + lo_rec(pm, pn, wr, wc, fr, fq);
#pragma unroll
                for (int i = 0; i < 8; ++i) { const size_t ro = (size_t)((i >> 2) * 128 + (i & 3) * 16) * DM; u32x4 lq;
#pragma unroll
                    for (int bj = 0; bj < 2; ++bj) { const f32x4 y0 = *(const GAS f32x4*)(src + ro + bj * 128), y1 = *(const GAS f32x4*)(src + ro + bj * 128 + 4);
                        u32x4 h; h.x = cvt_pk_bf16(y0[0], y0[1]); h.y = cvt_pk_bf16(y0[2], y0[3]); h.z = cvt_pk_bf16(y1[0], y1[1]); h.w = cvt_pk_bf16(y1[2], y1[3]);
                        const unsigned l0 = lo8_pack4(y0[0] - bf_lo(h.x), y0[1] - bf_hi(h.x), y0[2] - bf_lo(h.y), y0[3] - bf_hi(h.y)), l1 = lo8_pack4(y1[0] - bf_lo(h.z), y1[1] - bf_hi(h.z), y1[2] - bf_lo(h.w), y1[3] - bf_hi(h.w));
                        *(GAS u32x4*)((GAS unsigned char*)XB + pg8::atile_byte(row0 + (i >> 2) * 128 + (i & 3) * 16, col0 + bj * 128, DM)) = h; if (bj == 0) { lq.x = l0; lq.y = l1; } else { lq.z = l0; lq.w = l1; } }
                    *(GAS u32x4*)(lrec + i * 1024) = lq; }
            }
        }
    }
    GRID_BAR();

    for (int sl = 0; sl < 12; ++sl) {
        const int li = sl / 3, kind = sl - 3 * li;
        PHASE_LOCALS();
        const bf16_t* Ares; int lda_res, Kres; const bf16_t* Wres; float sres;
        const float* stats_old = sl ? STATS + (size_t)(sl - 1) * MTOK * 2 : nullptr;
        const pg8::LnFold FOLD{stats_old, C1 + (size_t)sl * CSTRIDE, C0 + (size_t)sl * CSTRIDE};
        bf16_t* SCR = (bf16_t*)(ws + WS_END); (void)SCR;
        if (kind != 1) {
            const int f = li * 2 + (kind >> 1);
            for (int rep = 0; rep < PROBE_GU; ++rep) {
            { pg8::Gemm g{XB, DM, DM, 1}; pg8::BPlain B{WGU + (size_t)f * 2 * DFF * DM, DM}; pg8::PanelOrder S; S.init(MTOK, 2 * DFF, G, vcu); pg8::EpiSwiGLU E{BIG, DFF, FOLD};
              pg8::gemm_phase<pg8::EpiSwiGLU, pg8::BPlain, pg8::PanelOrder>(lds, g, B, S, E, tid); }
            GROUP_SYNC();
            }
            Ares = BIG; lda_res = DFF; Kres = DFF; Wres = WD + (size_t)f * DM * DFF; sres = 0.5f * -0.6931471805599453f;
        } else if ((li & 1) == 0) {
            const int j = li >> 1;
            bf16_t* QKVB = BIG;
            for (int rep = 0; rep < PROBE_QKV; ++rep) {
            { pg8::Gemm g{XB, DM, DM, 1}; pg8::BPlain B{NAQKV + (size_t)j * 6144 * DM, DM}; pg8::PanelOrder S; S.init(MTOK, 6144, G, vcu); pg8::EpiBf16P E{QKVB, 6144, FOLD};
              pg8::gemm_phase<pg8::EpiBf16P, pg8::BPlain, pg8::PanelOrder>(lds, g, B, S, E, tid); }
            GRID_BAR();
            }
            for (int rep = PROBE_ATT - 1; rep >= 0; --rep) {
                const float* rpb = args.in[9] + (size_t)j * 16 * 465;
                GAS bf16_t* O = rep ? (GAS bf16_t*)SCR : (GAS bf16_t*)out; const int ldo = 2048;
                na_phase(lds, (const GAS bf16_t*)QKVB, O, ldo, rpb, vcu, G, tid, lane, wave);
                GRID_BAR();
            }
            Ares = (const bf16_t*)out; lda_res = 2048; Kres = DM; Wres = NAO + (size_t)j * DM * DM; sres = 1.0f;
        } else {
            const int j = li >> 1;
            bf16_t* QKVB = BIG;
            for (int rep = 0; rep < PROBE_QKV; ++rep) {
            { pg8::Gemm g{XB, DM, DM, 1}; pg8::BPlain B{DQKV + (size_t)j * 9216 * DM, DM}; pg8::PanelOrder S; S.init(MTOK, 9216, G, vcu); pg8::EpiBf16P E{QKVB, 9216, FOLD};
              pg8::gemm_phase<pg8::EpiBf16P, pg8::BPlain, pg8::PanelOrder>(lds, g, B, S, E, tid); }
            GRID_BAR();
            }
            for (int rep = PROBE_ATT - 1; rep >= 0; --rep) {
                GAS bf16_t* O = rep ? (GAS bf16_t*)SCR : (GAS bf16_t*)QKVB; const int ldo = rep ? 3072 : 9216, gstride = rep ? 1024 : 3072;
                dil_phase(lds, (const GAS bf16_t*)QKVB, O, ldo, gstride, (GAS float*)LSE, args.in[12], vcu, G, tid, lane, wave);
                GRID_BAR();
            }
            for (int rep = PROBE_ATT - 1; rep >= 0; --rep) {
            GAS bf16_t* MO = rep ? (GAS bf16_t*)SCR : (GAS bf16_t*)out; const int ldm = 1024;
            for (int tok = gw; tok < MTOK; tok += NGW) {
                const int h = lane >> 3, c16 = (lane & 7) * 16;
                const GAS float* lp = (const GAS float*)LSE + (size_t)tok * 24 + h;
                const float l0 = lp[0], l1 = lp[8], l2 = lp[16];
                const float m = fmaxf(l0, fmaxf(l1, l2));
                float w0 = __builtin_amdgcn_exp2f(l0 - m), w1 = __builtin_amdgcn_exp2f(l1 - m), w2 = __builtin_amdgcn_exp2f(l2 - m);
                const float inv = 1.0f / (w0 + w1 + w2); w0 *= inv; w1 *= inv; w2 *= inv;
                const GAS bf16_t* base = (const GAS bf16_t*)QKVB + (size_t)tok * 9216 + h * 128 + c16;
                GAS bf16_t* obase = MO + (size_t)tok * ldm + h * 128 + c16;
#pragma unroll
                for (int hf = 0; hf < 2; ++hf) {
                    const u32x4 a0 = *(const GAS u32x4*)(base + hf * 8), a1 = *(const GAS u32x4*)(base + 3072 + hf * 8), a2 = *(const GAS u32x4*)(base + 6144 + hf * 8);
                    u32x4 w;
#pragma unroll
                    for (int k = 0; k < 4; ++k) {
                        const float lo = w0 * bf_lo(a0[k]) + w1 * bf_lo(a1[k]) + w2 * bf_lo(a2[k]);
                        const float hi = w0 * bf_hi(a0[k]) + w1 * bf_hi(a1[k]) + w2 * bf_hi(a2[k]);
                        w[k] = cvt_pk_bf16(lo, hi);
                    }
                    *(GAS u32x4*)(obase + hf * 8) = w;
                }
            }
            GRID_BAR();
            }
            Ares = (const bf16_t*)out; lda_res = 1024; Kres = 1024; Wres = DOW + (size_t)j * DM * 1024; sres = 1.0f;
        }
#if PROBE_RESK == 4
        { pg8::Gemm g{Ares, lda_res, Kres, kind != 1 ? 1 : 0}; pg8::BPlain B{Wres, Kres}; pg8::StaticOrder S; S.init(MTOK, DM, G, bx);
          pg8::EpiResidLn E{XB, YLO, DM, ALPHA, sres, stats_old, args.in[2] + (size_t)(sl ? sl - 1 : 0) * DM, args.in[3] + (size_t)(sl ? sl - 1 : 0) * DM, (float*)SCR};
          E.YHo = (bf16_t*)out; E.YLo = (unsigned char*)out + (size_t)MTOK * DM * 2;
          pg8::gemm_phase<pg8::EpiResidLn, pg8::BPlain, pg8::StaticOrder>(lds, g, B, S, E, tid); GRID_BAR(); }
#endif
        for (int rep = 0; rep < ((PROBE_RESK && PROBE_RESK != 4) ? 1 : 0); ++rep) { pg8::Gemm g{Ares, lda_res, Kres, kind != 1 ? 1 : 0}; pg8::BPlain B{Wres, Kres}; pg8::StaticOrder S; S.init(MTOK, DM, G, bx); pg8::EpiNull E{out, SCR};
          pg8::gemm_phase<pg8::EpiNull, pg8::BPlain, pg8::StaticOrder>(lds, g, B, S, E, tid); GRID_BAR(); }
        if (STAG_US) { const unsigned long long t0 = __builtin_amdgcn_s_memrealtime(), dl = (unsigned long long)((vcu & 3) * STAG_US * 100);
          while (__builtin_amdgcn_s_memrealtime() - t0 < dl) __builtin_amdgcn_s_sleep(8);
          __syncthreads(); }
        { pg8::Gemm g{Ares, lda_res, Kres, kind != 1 ? 1 : 0}; pg8::BPlain B{Wres, Kres}; pg8::PanelOrder S; S.init(MTOK, DM, G, vcu);
          pg8::EpiResidLn E{XB, YLO, DM, ALPHA, sres, stats_old, args.in[2] + (size_t)(sl ? sl - 1 : 0) * DM, args.in[3] + (size_t)(sl ? sl - 1 : 0) * DM, STATS + (size_t)sl * MTOK * 2};
          pg8::gemm_phase<pg8::EpiResidLn, pg8::BPlain, pg8::PanelOrder>(lds, g, B, S, E, tid); }
        if (kind == 0 || sl == 11) GRID_BAR(); else GROUP_SYNC();
    }
    {
        PHASE_LOCALS();
#if PROBE_IDLE
        if (tid == 0) atomicAdd((unsigned*)(ws + WS_CTL) + 64, idle_ticks);
        GRID_BAR();
#endif
        {
            const int wr = wave >> 2, wc = wave & 3, fr = lane & 15, fq = lane >> 4;
            const pg8::LnFold Fin{STATS + (size_t)11 * MTOK * 2, nullptr, nullptr};
            const float* g11 = args.in[2] + (size_t)11 * DM; const float* b11 = args.in[3] + (size_t)11 * DM;
            for (int t = vcu; t < (MTOK / 256) * 8; t += G) {
                const int pm = t >> 3, pn = t & 7, row0 = pm * 256 + wr * 64 + fr, col0 = pn * 256 + wc * 32 + 8 * fq;
                const unsigned char* lrec = YLO + lo_rec(pm, pn, wr, wc, fr, fq);
                f32x4 gv[2][2], bv[2][2];
#pragma unroll
                for (int bj = 0; bj < 2; ++bj)
#pragma unroll
                    for (int n = 0; n < 2; ++n) { gv[bj][n] = *(const GAS f32x4*)(g11 + col0 + bj * 128 + 4 * n); bv[bj][n] = *(const GAS f32x4*)(b11 + col0 + bj * 128 + 4 * n); }
#pragma unroll
                for (int i = 0; i < 8; ++i) { const int row = row0 + (i >> 2) * 128 + (i & 3) * 16;
                    float mu, rstd; Fin.row(row, mu, rstd);
                    const u32x4 L = *(const GAS u32x4*)(lrec + i * 1024);
#pragma unroll
                    for (int bj = 0; bj < 2; ++bj) { const u32x4 h = *(const GAS u32x4*)((const GAS unsigned char*)XB + pg8::atile_byte(row, col0 + bj * 128, DM));
                        const f32x4 y0 = (f32x4){bf_lo(h.x), bf_hi(h.x), bf_lo(h.y), bf_hi(h.y)} + lo8_unpack4(bj ? L.z : L.x), y1 = (f32x4){bf_lo(h.z), bf_hi(h.z), bf_lo(h.w), bf_hi(h.w)} + lo8_unpack4(bj ? L.w : L.y);
                        GAS f32x4* op = (GAS f32x4*)(out + (size_t)row * DM + col0 + bj * 128);
                        op[0] = (y0 - mu) * (gv[bj][0] * rstd) + bv[bj][0]; op[1] = (y1 - mu) * (gv[bj][1] * rstd) + bv[bj][1]; } }
            }
        }
#if PROBE_IDLE
        if (bx == 0 && tid == 0) { asm volatile("s_waitcnt vmcnt(0)" ::: "memory"); const unsigned tot = __hip_atomic_load((unsigned*)(ws + WS_CTL) + 64, __ATOMIC_RELAXED, __HIP_MEMORY_SCOPE_AGENT); out[0] += (float)tot / (float)G * 1e-4f; }
#endif
    }
#undef GRID_BAR
}

extern "C" void kernel_launch(void* const* d_in, const int* in_sizes, int n_in, void* d_out, int out_size, void* d_ws, size_t ws_size, hipStream_t stream) {
    static int grid = 0;
    if (grid == 0) {
        if (n_in != 13 || out_size != MTOK * DM || ws_size < WS_END + (size_t)((PROBE_ATT > 1) ? (size_t)MTOK * 3072 * 2 : 0)) { fprintf(stderr, "kernel_launch: unexpected shapes (n_in %d, out %d, ws %zu < %zu); nothing launched\n", n_in, out_size, ws_size, (size_t)WS_END); grid = -1; return; }
        int dev = 0, cus = 0, per_cu = 0;
        if (hipGetDevice(&dev) != hipSuccess || hipDeviceGetAttribute(&cus, hipDeviceAttributeMultiprocessorCount, dev) != hipSuccess) { grid = -1; return; }
        if (hipFuncSetAttribute((const void*)fwd, hipFuncAttributeMaxDynamicSharedMemorySize, LDS_BYTES) != hipSuccess) { fprintf(stderr, "kernel_launch: hipFuncSetAttribute failed\n"); grid = -1; return; }
        if (hipOccupancyMaxActiveBlocksPerMultiprocessor(&per_cu, (const void*)fwd, NWAVES * 64, LDS_BYTES) != hipSuccess || per_cu < 1)
            fprintf(stderr, "kernel_launch: note: occupancy query reports %d workgroups per CU\n", per_cu);
        (void)hipGetLastError();
        if (cus < 256) { fprintf(stderr, "kernel_launch: %d CUs; the row-panel ownership needs 256 resident workgroups; nothing launched\n", cus); grid = -1; return; }
        grid = 256;
    }
    if (grid < 0) return;
    if (hipMemsetAsync((char*)d_ws + WS_CTL, 0, CTL_ZERO_BYTES, stream) != hipSuccess) { fprintf(stderr, "kernel_launch: memset failed\n"); return; }
    Args a{};
    for (int i = 0; i < 13; ++i) a.in[i] = (const float*)d_in[i];
    a.out = (float*)d_out; a.ws = (unsigned char*)d_ws;
    hipLaunchKernelGGL(fwd, dim3(grid), dim3(NWAVES * 64), LDS_BYTES, stream, a);
    const hipError_t le = hipPeekAtLastError();
    if (le != hipSuccess) fprintf(stderr, "kernel_launch: launch failed: %s\n", hipGetErrorName(le));
}
```

```cpp
#include <hip/hip_runtime.h>
#include <cstdio>
#include <cstdint>

#define GAS __attribute__((address_space(1)))
#define LAS __attribute__((address_space(3)))
typedef unsigned short bf16_t;
typedef short bf16x8 __attribute__((ext_vector_type(8)));
typedef float f32x4 __attribute__((ext_vector_type(4)));
typedef unsigned u32x4 __attribute__((ext_vector_type(4)));
typedef unsigned u32x2 __attribute__((ext_vector_type(2)));
typedef float f32x2 __attribute__((ext_vector_type(2)));

#ifndef PROBE_GU
#define PROBE_GU 1
#endif
#ifndef PROBE_QKV
#define PROBE_QKV 1
#endif
#ifndef PROBE_ATT
#define PROBE_ATT 1
#endif
#ifndef PROBE_LN
#define PROBE_LN 1
#endif
#ifndef PROBE_IDLE
#define PROBE_IDLE 0
#endif
#ifndef STAG_US
#define STAG_US 0
#endif
#ifndef PROBE_RESK
#define PROBE_RESK 0
#endif
#ifndef PROBE_P0
#define PROBE_P0 1
#endif
constexpr int DM = 2048, DFF = 5632;
constexpr int MTOK = 32768, PROMPT_TOK = 16384;
constexpr float ALPHA = 1.6817928305074290f;
constexpr float LN_EPS = 1e-5f;
constexpr float LOG2E = 1.4426950408889634f;
constexpr float QK_SCALE2 = 0.08838834764831845f * 1.4426950408889634f;

__device__ __forceinline__ unsigned cvt_pk_bf16(float lo, float hi) { unsigned r; asm volatile("v_cvt_pk_bf16_f32 %0, %1, %2" : "=v"(r) : "v"(lo), "v"(hi)); return r; }
__device__ __forceinline__ float bf_lo(unsigned w) { return __builtin_bit_cast(float, w << 16); }
__device__ __forceinline__ float bf_hi(unsigned w) { return __builtin_bit_cast(float, w & 0xffff0000u); }
__device__ __forceinline__ int lane_id_fresh() { int l; asm volatile("v_mbcnt_lo_u32_b32 %0, -1, 0\n\tv_mbcnt_hi_u32_b32 %0, -1, %0" : "=&v"(l)); return l; }
constexpr float LO_SCALE = 512.f, LO_INV = 1.f / 512.f;
__device__ __forceinline__ unsigned lo8_pack4(float a, float b, float c, float d) { int v = __builtin_amdgcn_cvt_pk_fp8_f32(a * LO_SCALE, b * LO_SCALE, 0, false); v = __builtin_amdgcn_cvt_pk_fp8_f32(c * LO_SCALE, d * LO_SCALE, v, true); return (unsigned)v; }
__device__ __forceinline__ unsigned lo8_pack4s(float a, float b, float c, float d) { int v = __builtin_amdgcn_cvt_pk_fp8_f32(a, b, 0, false); v = __builtin_amdgcn_cvt_pk_fp8_f32(c, d, v, true); return (unsigned)v; }
__device__ __forceinline__ f32x4 lo8_unpack4(unsigned v) { const auto a = __builtin_amdgcn_cvt_pk_f32_fp8((int)v, false), b = __builtin_amdgcn_cvt_pk_f32_fp8((int)v, true); return (f32x4){a[0], a[1], b[0], b[1]} * LO_INV; }
__device__ __forceinline__ size_t lo_rec(int pm, int pn, int wr, int wc, int fr, int fq) { return ((size_t)(pm * 8 + pn) * 8 + (wr * 4 + wc)) * 8192 + (size_t)(fq * 16 + fr) * 16; }
__device__ __forceinline__ size_t lo_rowcol(int row, int j, int lane) {
    const int pm = row >> 8, r = row & 255, ai = r >> 7, wr = (r >> 6) & 1, mm = (r >> 4) & 3, fr = r & 15;
    const int bj = lane >> 5, wc = (lane >> 3) & 3, fq = (lane >> 1) & 3, n = lane & 1;
    return lo_rec(pm, j, wr, wc, fr, fq) + (size_t)((ai * 4 + mm) * 1024 + bj * 8 + n * 4);
}
__device__ __forceinline__ int imin(int a, int b) { return a < b ? a : b; }
__device__ __forceinline__ int imax(int a, int b) { return a > b ? a : b; }

namespace pg8 {
constexpr int BM = 256, BK = 64, HALF = 128, HTB = HALF * BK * 2  , STAGE_BYTES = 8 * HTB, NXCD = 8, WGM = 8;
__host__ __device__ __forceinline__ int lds_byte(int r, int c) { const int st = (r >> 4) * 2 + (c >> 5), rr = r & 15, cc = c & 31, ob = rr * 64 + cc * 2; return st * 1024 + (ob ^ (((ob >> 9) & 1) << 5)); }
__host__ __device__ __forceinline__ void stage_rc(int b, int& R, int& C) { const int st = b / 1024, sb = b % 1024, swz = sb ^ (((sb >> 9) & 1) << 5); R = (st >> 1) * 16 + swz / 64; C = (st & 1) * 32 + (swz % 64) / 2; }
__host__ __device__ __forceinline__ int perm32(int rho) { const int n = rho >> 4, i = rho & 15; return 8 * (i >> 2) + 4 * n + (i & 3); }

struct Unit { int pm, pn; };
struct Gemm { const bf16_t* A; int lda; int K; int tiled; };
__host__ __device__ __forceinline__ int lds_byte(int r, int c);
__device__ __forceinline__ size_t atile_byte(int row, int col, int lda) { const int rl = row & 255;
    return ((((size_t)(row >> 8) * (lda >> 6)) + (col >> 6)) * 2 + (rl >> 7)) * 16384 + (size_t)lds_byte(rl & 127, col & 63); }

struct StaticOrder {
    int nM, nN, nwg, G, c;
    __device__ void init(int M, int N, int G_, int c_) { nM = M / BM; nN = N / BM; nwg = nM * nN; G = G_; c = c_; }
    __device__ bool next(int i, Unit& u) const {
        const long L = (long)i * G + c; if (L >= nwg) return false;
        int wgid = (int)L; { const int q = nwg / NXCD, r = nwg % NXCD, xcd = wgid % NXCD, off = wgid / NXCD; wgid = (xcd < r ? xcd * (q + 1) : r * (q + 1) + (xcd - r) * q) + off; }
        const int nig = WGM * nN, gid = wgid / nig, fm = gid * WGM, gsz = (nM - fm) < WGM ? (nM - fm) : WGM;
        u.pm = fm + ((wgid % nig) % gsz); u.pn = (wgid % nig) / gsz; return true;
    }
};
constexpr int GS = 4;
struct PanelOrder {
    int per, tot, pm0, pn0;
    __device__ void init(int, int N, int, int c) { per = (N / BM) / GS; tot = (GS / 2) * per; pm0 = (c / GS) * (GS / 2); pn0 = (c % GS) * per; }
    __device__ bool next(int i, Unit& u) const { if (i >= tot) return false; const int q = i / per; u.pm = pm0 + q; u.pn = pn0 + (i - q * per); return true; }
};
struct BPlain { const bf16_t* Bt; int K;
    __device__ __forceinline__ const char* half(const Unit& u, int hh) const { return (const char*)Bt + ((size_t)u.pn * (K / BK) * 2 + hh) * 16384; } };
__device__ __forceinline__ size_t wtile_byte(int n, int k, int K) {
    const int pn = n >> 8, nl = n & 255, h = nl >> 7, r128 = nl & 127, gq = r128 >> 5, cc = r128 & 31;
    const int rho = ((cc >> 2) & 1) * 16 + ((cc >> 3) << 2) + (cc & 3);
    return (((size_t)pn * (K / BK) + (k >> 6)) * 2 + h) * 16384 + (size_t)lds_byte(gq * 32 + rho, k & 63);
}
struct LnFold { const float* stats; const float* c1; const float* c0;
    __device__ __forceinline__ void row(int r, float& mu, float& rstd) const {
        if (stats) { const f32x2 st = *(const f32x2*)(stats + 2 * (size_t)r); mu = st.x * (1.0f / DM); rstd = __builtin_amdgcn_rsqf(fmaxf(st.y * (1.0f / DM) - mu * mu, 0.f) + LN_EPS);     } else { mu = 0.f; rstd = 1.f; } }
    static constexpr int TBL_OFF = 131072, TBL_BYTES = 4096;
    __device__ __forceinline__ void prefetch(LAS unsigned char* lds, int par, int row0u, int col0u, int wid, int lane) const {
        LAS unsigned char* t = lds + TBL_OFF + par * TBL_BYTES;
        if (stats) __builtin_amdgcn_global_load_lds((const unsigned*)(stats + 2 * (size_t)(row0u + 32 * wid) + lane), (LAS unsigned*)(t + wid * 256), 4, 0, 0);
        const float* cs = (wid < 4 ? c1 : c0) + col0u + 64 * (wid & 3) + lane;
        __builtin_amdgcn_global_load_lds((const unsigned*)cs, (LAS unsigned*)(t + 2048 + wid * 256), 4, 0, 0);
    }
    __device__ __forceinline__ void row_lds(const LAS unsigned char* lds, int par, int rl, float& mu, float& rstd) const {
        if (stats) { const f32x2 st = *(const LAS f32x2*)(lds + TBL_OFF + par * TBL_BYTES + 8 * rl); mu = st.x * (1.0f / DM); rstd = __builtin_amdgcn_rsqf(fmaxf(st.y * (1.0f / DM) - mu * mu, 0.f) + LN_EPS);     } else { mu = 0.f; rstd = 1.f; } }
    __device__ __forceinline__ f32x4 c1_lds(const LAS unsigned char* lds, int par, int cl) const { return *(const LAS f32x4*)(lds + TBL_OFF + par * TBL_BYTES + 2048 + 4 * cl); }
    __device__ __forceinline__ f32x4 c0_lds(const LAS unsigned char* lds, int par, int cl) const { return *(const LAS f32x4*)(lds + TBL_OFF + par * TBL_BYTES + 3072 + 4 * cl); }
};
struct EpiBf16P {
    static constexpr bool PERM = true;
    bf16_t* O; int ldc; LnFold F;
    __device__ __forceinline__ void prefetch(LAS unsigned char* lds, int par, const Unit& u, int wid, int lane) const { F.prefetch(lds, par, u.pm * BM, u.pn * BM, wid, lane); }
    __device__ __forceinline__ void init(f32x4 (&acc)[2][2][4][2], const Unit&, int, int, int, int) const {
#pragma unroll
        for (int a = 0; a < 2; ++a)
#pragma unroll
            for (int b = 0; b < 2; ++b)
#pragma unroll
                for (int m = 0; m < 4; ++m)
#pragma unroll
                    for (int n = 0; n < 2; ++n) acc[a][b][m][n] = (f32x4){0.f, 0.f, 0.f, 0.f};
    }
    __device__ __forceinline__ void operator()(const f32x4 (&acc)[2][2][4][2], const Unit& u, int wr, int wc, int fr, int fq, const LAS unsigned char* lds, int par) const {
        const int row0 = u.pm * BM + wr * 64 + fr, col0 = u.pn * BM + wc * 32 + 8 * fq;
        float mu[8], rstd[8];
#pragma unroll
        for (int i = 0; i < 8; ++i) F.row_lds(lds, par, wr * 64 + fr + (i >> 2) * HALF + (i & 3) * 16, mu[i], rstd[i]);
        f32x4 c1v[2][2], c0v[2][2];
#pragma unroll
        for (int bj = 0; bj < 2; ++bj)
#pragma unroll
            for (int n = 0; n < 2; ++n) { c1v[bj][n] = F.c1_lds(lds, par, wc * 32 + 8 * fq + bj * HALF + 4 * n); c0v[bj][n] = F.c0_lds(lds, par, wc * 32 + 8 * fq + bj * HALF + 4 * n); }
#pragma unroll
        for (int ai = 0; ai < 2; ++ai)
#pragma unroll
            for (int m = 0; m < 4; ++m) { const int row = row0 + ai * HALF + m * 16; bf16_t* rowp = O + (size_t)row * ldc + col0;
                const float mu_ = mu[ai * 4 + m], rs_ = rstd[ai * 4 + m];
#pragma unroll
                for (int bj = 0; bj < 2; ++bj) { const f32x4 v0 = (acc[ai][bj][m][0] - c1v[bj][0] * mu_) * rs_ + c0v[bj][0], v1 = (acc[ai][bj][m][1] - c1v[bj][1] * mu_) * rs_ + c0v[bj][1];
                    u32x4 w; w.x = cvt_pk_bf16(v0[0], v0[1]); w.y = cvt_pk_bf16(v0[2], v0[3]); w.z = cvt_pk_bf16(v1[0], v1[1]); w.w = cvt_pk_bf16(v1[2], v1[3]);
                    *(u32x4*)(rowp + bj * HALF) = w; } }
    }
};
__device__ __forceinline__ float silu_mul(float gs, float u) { return gs * u * __builtin_amdgcn_rcpf(1.0f + __builtin_amdgcn_exp2f(gs)); }
__device__ __forceinline__ f32x4 silu_mul4(const f32x4 gs, const f32x4 u) {
    const f32x4 e = (f32x4){__builtin_amdgcn_exp2f(gs[0]), __builtin_amdgcn_exp2f(gs[1]), __builtin_amdgcn_exp2f(gs[2]), __builtin_amdgcn_exp2f(gs[3])} + 1.0f;
    const f32x4 r = {__builtin_amdgcn_rcpf(e[0]), __builtin_amdgcn_rcpf(e[1]), __builtin_amdgcn_rcpf(e[2]), __builtin_amdgcn_rcpf(e[3])};
    return (gs * u) * r;
}
struct EpiSwiGLU {
    static constexpr bool PERM = true;
    bf16_t* H; int ldc; LnFold F;
    __device__ __forceinline__ void prefetch(LAS unsigned char* lds, int par, const Unit& u, int wid, int lane) const { F.prefetch(lds, par, u.pm * BM, u.pn * BM, wid, lane); }
    __device__ __forceinline__ void init(f32x4 (&acc)[2][2][4][2], const Unit&, int, int, int, int) const {
#pragma unroll
        for (int a = 0; a < 2; ++a)
#pragma unroll
            for (int b = 0; b < 2; ++b)
#pragma unroll
                for (int m = 0; m < 4; ++m)
#pragma unroll
                    for (int n = 0; n < 2; ++n) acc[a][b][m][n] = (f32x4){0.f, 0.f, 0.f, 0.f};
    }
    __device__ __forceinline__ void operator()(const f32x4 (&acc)[2][2][4][2], const Unit& u, int wr, int wc, int fr, int fq, const LAS unsigned char* lds, int par) const {
        const int row0 = u.pm * BM + wr * 64 + fr, col0 = u.pn * HALF + wc * 32 + 8 * fq, ccol0 = u.pn * BM + wc * 32 + 8 * fq;
        float mu[8], rstd[8];
#pragma unroll
        for (int i = 0; i < 8; ++i) F.row_lds(lds, par, wr * 64 + fr + (i >> 2) * HALF + (i & 3) * 16, mu[i], rstd[i]);
        f32x4 c1v[2][2], c0v[2][2];
#pragma unroll
        for (int bj = 0; bj < 2; ++bj)
#pragma unroll
            for (int n = 0; n < 2; ++n) { c1v[bj][n] = F.c1_lds(lds, par, wc * 32 + 8 * fq + bj * HALF + 4 * n); c0v[bj][n] = F.c0_lds(lds, par, wc * 32 + 8 * fq + bj * HALF + 4 * n); }
#pragma unroll
        for (int ai = 0; ai < 2; ++ai)
#pragma unroll
            for (int m = 0; m < 4; ++m) { const int row = row0 + ai * HALF + m * 16; bf16_t* rowp = (bf16_t*)((unsigned char*)H + atile_byte(row, col0, ldc));
                const float mu_ = mu[ai * 4 + m], rs_ = rstd[ai * 4 + m];
                const f32x4 g0 = (acc[ai][0][m][0] - c1v[0][0] * mu_) * rs_ + c0v[0][0], g1 = (acc[ai][0][m][1] - c1v[0][1] * mu_) * rs_ + c0v[0][1];
                const f32x4 u0 = (acc[ai][1][m][0] - c1v[1][0] * mu_) * rs_ + c0v[1][0], u1 = (acc[ai][1][m][1] - c1v[1][1] * mu_) * rs_ + c0v[1][1];
                const f32x4 s0 = silu_mul4(g0, u0), s1 = silu_mul4(g1, u1);
                u32x4 w; w.x = cvt_pk_bf16(s0[0], s0[1]); w.y = cvt_pk_bf16(s0[2], s0[3]); w.z = cvt_pk_bf16(s1[0], s1[1]); w.w = cvt_pk_bf16(s1[2], s1[3]);
                *(u32x4*)rowp = w; }
    }
};
struct EpiResidLn {
    static constexpr bool PERM = true;
    bf16_t* YH; unsigned char* YL; int ldc; float alpha, s; const float* stats_old; const float* g_old; const float* b_old; float* stats_new; bf16_t* YHo = nullptr; unsigned char* YLo = nullptr;
    __device__ __forceinline__ void prefetch(LAS unsigned char*, int, const Unit&, int, int) const {}
#define RL_LD16(dst_, ptr_) asm volatile("global_load_dwordx4 %0, %1, off" : "=v"(dst_) : "v"((const GAS void*)(ptr_)) : "memory")
#define RL_LD8(dst_, ptr_)  asm volatile("global_load_dwordx2 %0, %1, off" : "=v"(dst_) : "v"((const GAS void*)(ptr_)) : "memory")
    __device__ __forceinline__ void init(f32x4 (&acc)[2][2][4][2], const Unit& u, int wr, int wc, int fr, int fq) const {
        const int row0 = u.pm * BM + wr * 64 + fr, col0 = u.pn * BM + wc * 32 + 8 * fq;
        f32x2 st[8];
        const float* sp = stats_old ? stats_old : stats_new;
#pragma unroll
        for (int i = 0; i < 8; ++i) RL_LD8(st[i], sp + 2 * (size_t)(row0 + (i >> 2) * HALF + (i & 3) * 16));
        f32x4 gl[2][2], bl[2][2];
#pragma unroll
        for (int bj = 0; bj < 2; ++bj)
#pragma unroll
            for (int n = 0; n < 2; ++n) { RL_LD16(gl[bj][n], g_old + col0 + bj * HALF + 4 * n); RL_LD16(bl[bj][n], b_old + col0 + bj * HALF + 4 * n); }
        const unsigned char* lrec = YL + lo_rec(u.pm, u.pn, wr, wc, fr, fq);
        u32x4 L[8], H0[8], H1[8];
#pragma unroll
        for (int i = 0; i < 8; ++i) { const int ai = i >> 2, m = i & 3; const int row = row0 + ai * HALF + m * 16;
            RL_LD16(L[i], lrec + i * 1024); RL_LD16(H0[i], (const unsigned char*)YH + atile_byte(row, col0, ldc)); RL_LD16(H1[i], (const unsigned char*)YH + atile_byte(row, col0 + HALF, ldc)); }
        asm volatile("s_waitcnt vmcnt(24)" : "+v"(st[0]), "+v"(st[1]), "+v"(st[2]), "+v"(st[3]), "+v"(st[4]), "+v"(st[5]), "+v"(st[6]), "+v"(st[7]),
                     "+v"(gl[0][0]), "+v"(gl[0][1]), "+v"(gl[1][0]), "+v"(gl[1][1]), "+v"(bl[0][0]), "+v"(bl[0][1]), "+v"(bl[1][0]), "+v"(bl[1][1]) :: "memory");
        const float k = alpha / s;
        f32x4 gv[2][2], bv[2][2];
#pragma unroll
        for (int bj = 0; bj < 2; ++bj)
#pragma unroll
            for (int n = 0; n < 2; ++n) { gv[bj][n] = stats_old ? gl[bj][n] * k : (f32x4){k, k, k, k}; bv[bj][n] = stats_old ? bl[bj][n] * k : (f32x4){0.f, 0.f, 0.f, 0.f}; }
#define RL_GROUP(i_, cnt_) do { constexpr int ai = (i_) >> 2, m = (i_) & 3; \
            asm volatile("s_waitcnt vmcnt(" #cnt_ ")" : "+v"(L[i_]), "+v"(H0[i_]), "+v"(H1[i_]) :: "memory"); \
            const float mus = st[i_].x * (1.0f / DM), rss = __builtin_amdgcn_rsqf(fmaxf(st[i_].y * (1.0f / DM) - mus * mus, 0.f) + LN_EPS); \
            const float mu_ = stats_old ? mus : 0.f, rs_ = stats_old ? rss : 1.f; \
            _Pragma("unroll") for (int bj = 0; bj < 2; ++bj) { const u32x4 h = bj ? H1[i_] : H0[i_]; \
                const f32x4 y0 = (f32x4){bf_lo(h.x), bf_hi(h.x), bf_lo(h.y), bf_hi(h.y)} + lo8_unpack4(bj ? L[i_].z : L[i_].x); \
                const f32x4 y1 = (f32x4){bf_lo(h.z), bf_hi(h.z), bf_lo(h.w), bf_hi(h.w)} + lo8_unpack4(bj ? L[i_].w : L[i_].y); \
                const f32x4 gr0 = gv[bj][0] * rs_, gr1 = gv[bj][1] * rs_;                    \
                acc[ai][bj][m][0] = y0 * gr0 + (bv[bj][0] - gr0 * mu_); acc[ai][bj][m][1] = y1 * gr1 + (bv[bj][1] - gr1 * mu_); \
                asm volatile("" : "+v"(acc[ai][bj][m][0]), "+v"(acc[ai][bj][m][1])); } } while (0)
        RL_GROUP(0, 21); RL_GROUP(1, 18); RL_GROUP(2, 15); RL_GROUP(3, 12); RL_GROUP(4, 9); RL_GROUP(5, 6); RL_GROUP(6, 3); RL_GROUP(7, 0);
#undef RL_GROUP
    }
#undef RL_LD16
#undef RL_LD8
    __device__ __forceinline__ void operator()(const f32x4 (&acc)[2][2][4][2], const Unit& u, int wr, int wc, int fr, int fq, const LAS unsigned char* lds, int par) const {
        const int row0 = u.pm * BM + wr * 64 + fr, col0 = u.pn * BM + wc * 32 + 8 * fq;
        float psum[8], psq[8];
#pragma unroll
        for (int i = 0; i < 8; ++i) { const int ai = i >> 2, m = i & 3; const int row = row0 + ai * HALF + m * 16; unsigned char* hp = (unsigned char*)(YHo ? YHo : YH);
            f32x4 vs = {0.f, 0.f, 0.f, 0.f}, vq = {0.f, 0.f, 0.f, 0.f}; u32x4 lq;
#pragma unroll
            for (int bj = 0; bj < 2; ++bj) { const f32x4 y0 = acc[ai][bj][m][0] * s, y1 = acc[ai][bj][m][1] * s;
                vs += y0 + y1; vq = y0 * y0 + vq; vq = y1 * y1 + vq;
                u32x4 h; h.x = cvt_pk_bf16(y0[0], y0[1]); h.y = cvt_pk_bf16(y0[2], y0[3]); h.z = cvt_pk_bf16(y1[0], y1[1]); h.w = cvt_pk_bf16(y1[2], y1[3]);
                const f32x4 r0 = y0 * LO_SCALE + (f32x4){bf_lo(h.x), bf_hi(h.x), bf_lo(h.y), bf_hi(h.y)} * (-LO_SCALE), r1 = y1 * LO_SCALE + (f32x4){bf_lo(h.z), bf_hi(h.z), bf_lo(h.w), bf_hi(h.w)} * (-LO_SCALE);
                u32x2 l; l.x = lo8_pack4s(r0[0], r0[1], r0[2], r0[3]); l.y = lo8_pack4s(r1[0], r1[1], r1[2], r1[3]);
                *(u32x4*)(hp + atile_byte(row, col0 + bj * HALF, ldc)) = h; if (bj == 0) { lq.x = l.x; lq.y = l.y; } else { lq.z = l.x; lq.w = l.y; } }
            float ps = (vs[0] + vs[1]) + (vs[2] + vs[3]), pss = (vq[0] + vq[1]) + (vq[2] + vq[3]);
            *(u32x4*)((YLo ? YLo : YL) + lo_rec(u.pm, u.pn, wr, wc, fr, fq) + i * 1024) = lq;
            ps += __shfl_xor(ps, 16); ps += __shfl_xor(ps, 32); pss += __shfl_xor(pss, 16); pss += __shfl_xor(pss, 32);
            psum[i] = ps; psq[i] = pss;
        }
#pragma unroll
        for (int ai = 0; ai < 2; ++ai)
#pragma unroll
            for (int k = 0; k < 2; ++k) { const int m = 2 * k + (fq >> 1);
                const float sv = (fq >> 1) ? psum[ai * 4 + 2 * k + 1] : psum[ai * 4 + 2 * k], qv = (fq >> 1) ? psq[ai * 4 + 2 * k + 1] : psq[ai * 4 + 2 * k];
                __hip_atomic_fetch_add(stats_new + 2 * (size_t)(row0 + ai * HALF + m * 16) + (fq & 1), (fq & 1) ? qv : sv, __ATOMIC_RELAXED, __HIP_MEMORY_SCOPE_AGENT); }
    }
};
struct EpiNull {
    static constexpr bool PERM = true;
    float* Y; bf16_t* DUM;
    __device__ __forceinline__ void prefetch(LAS unsigned char*, int, const Unit&, int, int) const {}
    __device__ __forceinline__ void init(f32x4 (&acc)[2][2][4][2], const Unit& u, int wr, int wc, int fr, int fq) const {
#if PROBE_RESK == 3
        const int row0 = u.pm * BM + wr * 64 + fr, col0 = u.pn * BM + wc * 32 + 8 * fq; const float* yb = Y + (size_t)row0 * DM + col0;
#pragma unroll
        for (int ai = 0; ai < 2; ++ai)
#pragma unroll
            for (int m = 0; m < 4; ++m)
#pragma unroll
                for (int bj = 0; bj < 2; ++bj)
#pragma unroll
                    for (int n = 0; n < 2; ++n) acc[ai][bj][m][n] = *(const f32x4*)(yb + (size_t)(ai * HALF + m * 16) * DM + bj * HALF + 4 * n) * 0.f;
#else
#pragma unroll
        for (int a = 0; a < 2; ++a)
#pragma unroll
            for (int b = 0; b < 2; ++b)
#pragma unroll
                for (int m = 0; m < 4; ++m)
#pragma unroll
                    for (int n = 0; n < 2; ++n) acc[a][b][m][n] = (f32x4){0.f, 0.f, 0.f, 0.f};
#endif
    }
    __device__ __forceinline__ void operator()(const f32x4 (&acc)[2][2][4][2], const Unit& u, int wr, int wc, int fr, int fq, const LAS unsigned char* lds, int par) const {
        float t = 0.f;
#pragma unroll
        for (int a = 0; a < 2; ++a)
#pragma unroll
            for (int b = 0; b < 2; ++b)
#pragma unroll
                for (int m = 0; m < 4; ++m)
#pragma unroll
                    for (int n = 0; n < 2; ++n) t += (acc[a][b][m][n][0] + acc[a][b][m][n][1]) + (acc[a][b][m][n][2] + acc[a][b][m][n][3]);
        if (t == 1.2345e38f) Y[u.pm + wr + wc + fr + fq] = t;
#if PROBE_RESK == 2
        const int row0 = u.pm * BM + wr * 64 + fr, col0 = u.pn * BM + wc * 32 + 8 * fq;
#pragma unroll
        for (int i = 0; i < 8; ++i) { bf16_t* browp = DUM + (size_t)(row0 + (i >> 2) * HALF + (i & 3) * 16) * DM + col0;
#pragma unroll
            for (int bj = 0; bj < 2; ++bj) { const f32x4 v0 = acc[i >> 2][bj][i & 3][0], v1 = acc[i >> 2][bj][i & 3][1];
                u32x4 w; w.x = cvt_pk_bf16(v0[0], v0[1]); w.y = cvt_pk_bf16(v0[2], v0[3]); w.z = cvt_pk_bf16(v1[0], v1[1]); w.w = cvt_pk_bf16(v1[2], v1[3]);
                *(u32x4*)(browp + bj * HALF) = w; } }
#endif
    }
};
template <class Epi, class BS, class ORD>
__device__ __forceinline__ void gemm_phase(LAS unsigned char* lds, const Gemm g, const BS B, const ORD& S, const Epi& E, int tid_in) {
    int tid = tid_in; asm volatile("" : "+v"(tid));
    const int wid = __builtin_amdgcn_readfirstlane(tid >> 6), lane = tid & 63, wr = wid >> 2, wc = wid & 3, fr = lane & 15, fq = lane >> 4;
    const int K = g.K, nt = K / BK, lda = g.lda;
    unsigned voffA[2], voffB[2];
#pragma unroll
    for (int i = 0; i < 2; ++i) { int R, C; stage_rc(tid * 16 + i * 8192, R, C); const int Rb = Epi::PERM ? ((R & ~31) + perm32(R & 31)) : R;
        voffA[i] = g.tiled ? (unsigned)(tid * 16 + i * 8192) : (unsigned)(R * lda + C) * 2u; voffB[i] = (unsigned)(tid * 16 + i * 8192); (void)Rb; }
    const size_t kstep = g.tiled ? (size_t)32768 : (size_t)(BK * 2), kstepB = 32768;
    const size_t hstepA = g.tiled ? (size_t)16384 : (size_t)HALF * lda * 2;
    const size_t tstepA = g.tiled ? (size_t)(lda >> 6) * 32768 : 2 * hstepA;
    const unsigned ldsw = (unsigned)wid * 1024u;
    const int aoff = lds_byte(wr * 64 + fr, fq * 8), boff = lds_byte(wc * 32 + fr, fq * 8);
#define PG8_SA(b, h) (((b) * 2 + (h)) * HTB)
#define PG8_SB(b, h) ((4 + (b) * 2 + (h)) * HTB)
#define PG8_STAGE(bufoff, gbase, voff) do { _Pragma("unroll") for (int _i = 0; _i < 2; ++_i) \
        __builtin_amdgcn_global_load_lds((const unsigned*)((const char*)(gbase) + (voff)[_i]), (LAS unsigned*)(lds + (bufoff) + ldsw + _i * 8192), 16, 0, 0); } while (0)
#define PG8_LDA(dst, b, h) do { _Pragma("unroll") for (int m = 0; m < 4; ++m) _Pragma("unroll") for (int k = 0; k < 2; ++k) dst[m][k] = *(const LAS bf16x8*)(lds + PG8_SA(b, h) + aoff + m * 2048 + k * 1024); } while (0)
#define PG8_LDB(dst, b, h) do { _Pragma("unroll") for (int n = 0; n < 2; ++n) _Pragma("unroll") for (int k = 0; k < 2; ++k) dst[n][k] = *(const LAS bf16x8*)(lds + PG8_SB(b, h) + boff + n * 2048 + k * 1024); } while (0)
#define PG8_MMA(ai, bj, At, Bt) do { __builtin_amdgcn_s_setprio(1); _Pragma("unroll") for (int m = 0; m < 4; ++m) _Pragma("unroll") for (int n = 0; n < 2; ++n) _Pragma("unroll") for (int k = 0; k < 2; ++k) \
        acc[ai][bj][m][n] = __builtin_amdgcn_mfma_f32_16x16x32_bf16(Bt[n][k], At[m][k], acc[ai][bj][m][n], 0, 0, 0); __builtin_amdgcn_s_setprio(0); } while (0)
#define PG8_WAIT_V(n) asm volatile("s_waitcnt vmcnt(" #n ")" ::: "memory")
#define PG8_WAIT_L(n) asm volatile("s_waitcnt lgkmcnt(" #n ")" ::: "memory")
#define PG8_BAR __builtin_amdgcn_s_barrier()
#define PG8_SCHED __builtin_amdgcn_sched_barrier(0)
    Unit cur, nxt; int ui = 0;
    if (!S.next(0, cur)) return;
    f32x4 acc[2][2][4][2];
    E.init(acc, cur, wr, wc, fr, fq);
    E.prefetch(lds, 0, cur, wid, lane);
    bf16x8 At[4][2], B0[2][2], B1[2][2];
    const char* cA = (const char*)g.A + (size_t)cur.pm * tstepA; const char* cB0 = B.half(cur, 0); const char* cB1 = B.half(cur, 1);
    PG8_STAGE(PG8_SB(0, 0), cB0, voffB); PG8_STAGE(PG8_SB(0, 1), cB1, voffB); PG8_STAGE(PG8_SA(0, 0), cA, voffA); PG8_STAGE(PG8_SA(0, 1), cA + hstepA, voffA);
    if (wr == 1) PG8_BAR;
    PG8_WAIT_V(2); PG8_BAR;
    PG8_STAGE(PG8_SB(1, 0), cB0 + kstepB, voffB); PG8_STAGE(PG8_SA(1, 0), cA + kstep, voffA); PG8_STAGE(PG8_SB(1, 1), cB1 + kstepB, voffB);
    PG8_WAIT_V(6); PG8_BAR;
    for (;;) {
        const bool has_next = S.next(ui + 1, nxt);
        const char* nA = has_next ? (const char*)g.A + (size_t)nxt.pm * tstepA : cA;
        const char* nB0 = has_next ? B.half(nxt, 0) : cB0; const char* nB1 = has_next ? B.half(nxt, 1) : cB1;
        for (int t = 0; t < nt; t += 2) {
            const bool last = (t == nt - 2);
            const char* a1 = cA + (size_t)(t + 1) * kstep;
            const char* a2 = last ? nA : cA + (size_t)(t + 2) * kstep;
            const char* b20 = last ? nB0 : cB0 + (size_t)(t + 2) * kstepB; const char* b21 = last ? nB1 : cB1 + (size_t)(t + 2) * kstepB;
            const char* a3 = a2 + kstep; const char* b30 = b20 + kstepB; const char* b31 = b21 + kstepB;
            PG8_LDB(B0, 0, 0); PG8_LDB(B1, 0, 1); PG8_SCHED; PG8_LDA(At, 0, 0); PG8_STAGE(PG8_SA(1, 1), a1 + hstepA, voffA);
            PG8_WAIT_V(8); PG8_WAIT_L(0); PG8_BAR; PG8_MMA(0, 0, At, B0); PG8_MMA(0, 1, At, B1); PG8_BAR; PG8_SCHED;
            PG8_LDA(At, 0, 1); PG8_STAGE(PG8_SB(0, 0), b20, voffB); PG8_STAGE(PG8_SB(0, 1), b21, voffB); PG8_STAGE(PG8_SA(0, 0), a2, voffA);
            PG8_WAIT_V(8); PG8_WAIT_L(0); PG8_BAR; PG8_MMA(1, 0, At, B0); PG8_MMA(1, 1, At, B1); PG8_BAR; PG8_SCHED;
            PG8_LDB(B0, 1, 0); PG8_LDB(B1, 1, 1); PG8_SCHED; PG8_LDA(At, 1, 0); PG8_STAGE(PG8_SA(0, 1), a2 + hstepA, voffA);
            PG8_WAIT_V(8); PG8_WAIT_L(0); PG8_BAR; PG8_MMA(0, 0, At, B0); PG8_MMA(0, 1, At, B1); PG8_BAR; PG8_SCHED;
            PG8_LDA(At, 1, 1); PG8_STAGE(PG8_SB(1, 0), b30, voffB); PG8_STAGE(PG8_SB(1, 1), b31, voffB); PG8_STAGE(PG8_SA(1, 0), a3, voffA);
            PG8_WAIT_V(8); PG8_WAIT_L(0); PG8_BAR; PG8_MMA(1, 0, At, B0); PG8_MMA(1, 1, At, B1); PG8_BAR; PG8_SCHED;
        }
        if (wr == 0) PG8_BAR;
        E(acc, cur, wr, wc, fr, fq, lds, ui & 1);
        if (!has_next) break;
        E.init(acc, nxt, wr, wc, fr, fq);
        E.prefetch(lds, (ui + 1) & 1, nxt, wid, lane);
        cur = nxt; cA = nA; cB0 = nB0; cB1 = nB1; ++ui;
        if (wr == 1) PG8_BAR;
    }
    PG8_WAIT_V(0);
    PG8_BAR;
#undef PG8_SA
#undef PG8_SB
#undef PG8_STAGE
#undef PG8_LDA
#undef PG8_LDB
#undef PG8_MMA
#undef PG8_WAIT_V
#undef PG8_WAIT_L
#undef PG8_BAR
#undef PG8_SCHED
}
}

constexpr size_t MiB = 1u << 20;
constexpr size_t WS_CTL = 0, CTL_ZERO_BYTES = 6 * MiB;
constexpr size_t WS_STATS = 1 * MiB;
constexpr size_t WS_C1 = 4 * MiB + 512 * 1024, WS_C0 = 5 * MiB + 256 * 1024;
constexpr int CSTRIDE = 2 * DFF;
static_assert(WS_STATS + (size_t)12 * MTOK * 2 * 4 <= WS_C1 && WS_C1 + (size_t)12 * CSTRIDE * 4 <= WS_C0 && WS_C0 + (size_t)12 * CSTRIDE * 4 <= CTL_ZERO_BYTES, "zeroed region");
constexpr size_t SZ_WGU1 = (size_t)2 * DFF * DM * 2, SZ_WD1 = (size_t)DM * DFF * 2;
constexpr size_t SZ_NAQKV1 = (size_t)3 * DM * DM * 2, SZ_NAO1 = (size_t)DM * DM * 2;
constexpr size_t SZ_DQKV1 = (size_t)9216 * DM * 2, SZ_DO1 = (size_t)DM * 1024 * 2;
constexpr size_t WS_WGU = 6 * MiB;
constexpr size_t WS_WD = WS_WGU + 8 * SZ_WGU1;
constexpr size_t WS_NAQKV = WS_WD + 8 * SZ_WD1;
constexpr size_t WS_NAO = WS_NAQKV + 2 * SZ_NAQKV1;
constexpr size_t WS_DQKV = WS_NAO + 2 * SZ_NAO1;
constexpr size_t WS_DO = WS_DQKV + 2 * SZ_DQKV1;
constexpr size_t WS_XB = WS_DO + 2 * SZ_DO1;
constexpr size_t WS_BIG = WS_XB + (size_t)MTOK * DM * 2;
constexpr size_t SZ_BIG = (size_t)MTOK * 9216 * 2;
constexpr size_t WS_LSE = WS_BIG + SZ_BIG;
constexpr size_t WS_YLO = WS_LSE + (size_t)MTOK * 24 * 4;
constexpr size_t WS_END = WS_YLO + (size_t)MTOK * DM * 2;
static_assert((size_t)MTOK * DFF * 2 <= SZ_BIG, "big buffer");
constexpr int CW_GRP = 8192;
constexpr int CW_BAR = 4096;

constexpr int RING_BYTES = 131072;
constexpr int CTLZ_OFF = 147456 + 2048;
constexpr int MISC_OFF = CTLZ_OFF + 320;
constexpr int LDS_BYTES = 150528;
constexpr int NWAVES = 8;

#define RLX_AGENT __ATOMIC_RELAXED, __HIP_MEMORY_SCOPE_AGENT
#define LDS_WAIT() asm volatile("s_waitcnt lgkmcnt(0)" ::: "memory")

#define XB_TMO      128
#define XB_XCNT(j)  (256  + 64 * (j))
#define XB_XSUB(j)  (1280 + 64 * (j))
#define XB_XGEN(j)  (2304 + 64 * (j))
#define XB_TOP      3328
#define XB_TOPGEN   3392
#define XCD_BAR_WORDS 3456
#define XB_SPIN_CAP (1u << 20)

__device__ __forceinline__ unsigned xb_ld(unsigned* p)              { return __hip_atomic_load(p, __ATOMIC_RELAXED, __HIP_MEMORY_SCOPE_AGENT); }
__device__ __forceinline__ unsigned xb_add(unsigned* p, unsigned v) { return __hip_atomic_fetch_add(p, v, __ATOMIC_RELAXED, __HIP_MEMORY_SCOPE_AGENT); }
__device__ __forceinline__ unsigned xb_xcc_id() { return (unsigned)__builtin_amdgcn_s_getreg((3 << 11) | 20) & 0xFu; }
#define XB_SPIN(cond, bar) do { unsigned _sp = 0; while (cond) { __builtin_amdgcn_s_sleep(1); \
    if ((++_sp & 255u) == 0u) { if (xb_ld(&(bar)[XB_TMO])) break; if (_sp > XB_SPIN_CAP) { atomicAdd(&(bar)[XB_TMO], 1u); break; } } } } while (0)

__device__ __forceinline__ void xcd_barrier_post(unsigned* bar) {
    const unsigned x = xb_xcc_id();
    if (threadIdx.x == 0) (void)xb_add(&bar[XB_XCNT(x)], 1u);
}
__device__ __forceinline__ void xcd_barrier_complete(unsigned* bar, unsigned x, unsigned& nloc, unsigned& nx) {
    const unsigned G = gridDim.x * gridDim.y * gridDim.z;
    unsigned sum, cnt, mine, sp = 0u;
    for (;;) {
        sum = 0u; cnt = 0u; mine = 0u;
#pragma unroll
        for (unsigned j = 0; j < 16; ++j) { const unsigned c = xb_ld(&bar[XB_XCNT(j)]); sum += c; cnt += (c > 0u) ? 1u : 0u; mine = (j == x) ? c : mine; }
        if (sum == G) break;
        __builtin_amdgcn_s_sleep(1);
        if ((++sp & 255u) == 0u) { if (xb_ld(&bar[XB_TMO])) break; if (sp > XB_SPIN_CAP) { atomicAdd(&bar[XB_TMO], 1u); break; } }
    }
    nloc = mine > 0u ? mine : 1u; nx = cnt > 0u ? cnt : 1u;
}
__device__ __forceinline__ void xcd_barrier(unsigned* bar, volatile LAS unsigned* st, bool leader) {
    asm volatile("s_waitcnt vmcnt(0)" ::: "memory");
    __syncthreads();
    if (leader) {
        const unsigned x = xb_xcc_id();
        __builtin_amdgcn_s_waitcnt(0);
        unsigned nloc = st[0], nx = st[1];
        if (nloc == 0u) { xcd_barrier_complete(bar, x, nloc, nx); st[0] = nloc; st[1] = nx; }
        const unsigned old = xb_add(&bar[XB_XSUB(x)], 1u);
        const unsigned gen = old / nloc;
        if (old + 1u == (gen + 1u) * nloc) {
            __builtin_amdgcn_fence(__ATOMIC_RELEASE, "agent");
            asm volatile("s_waitcnt vmcnt(0)" ::: "memory");
            const unsigned og = xb_add(&bar[XB_TOP], 1u);
            const unsigned tg = og / nx;
            if (og + 1u == (tg + 1u) * nx) xb_add(&bar[XB_TOPGEN], 1u);
            else XB_SPIN(xb_ld(&bar[XB_TOPGEN]) == tg, bar);
            __builtin_amdgcn_fence(__ATOMIC_ACQUIRE, "agent");
            xb_add(&bar[XB_XGEN(x)], 1u);
            asm volatile("s_waitcnt vmcnt(0)" ::: "memory");
        } else {
            XB_SPIN(xb_ld(&bar[XB_XGEN(x)]) == gen, bar);
            __builtin_amdgcn_fence(__ATOMIC_ACQUIRE, "agent");
            asm volatile("s_waitcnt vmcnt(0)" ::: "memory");
        }
    }
    __syncthreads();
}

__device__ __forceinline__ float wave_sum(float v) {
#pragma unroll
    for (int o = 1; o < 64; o <<= 1) v += __shfl_xor(v, o);
    return v;
}
__device__ __forceinline__ void transpose_item(const float* W, int K, int N, bf16_t* WT, int drow0, int k0, int n0, LAS float* scr, int lane, const float* gvec, const float* bvec, float* c1, float* c0, float wscale = 1.0f) {
#pragma unroll 8
    for (int i = 0; i < 32; ++i) { const int kk = 2 * i + (lane >> 5); scr[kk * 33 + (lane & 31)] = W[(size_t)(k0 + kk) * N + n0 + (lane & 31)]; }
    LDS_WAIT(); asm volatile("" ::: "memory");
    const int c = lane & 7;
    float gk[8], bk[8];
#pragma unroll
    for (int i = 0; i < 8; ++i) { gk[i] = (gvec ? gvec[k0 + 8 * c + i] : 1.f) * wscale; bk[i] = (gvec ? bvec[k0 + 8 * c + i] : 0.f) * wscale; }
    float q1[4], q0[4];
#pragma unroll
    for (int j = 0; j < 4; ++j) { const int n = (lane >> 3) + 8 * j; const LAS float* sp = scr + (8 * c) * 33 + n;
        float w[8]; float p0 = 0.f;
#pragma unroll
        for (int i = 0; i < 8; ++i) { const float x = sp[i * 33]; w[i] = x * gk[i]; p0 += x * bk[i]; }
        u32x4 o; o.x = cvt_pk_bf16(w[0], w[1]); o.y = cvt_pk_bf16(w[2], w[3]); o.z = cvt_pk_bf16(w[4], w[5]); o.w = cvt_pk_bf16(w[6], w[7]);
        *(GAS u32x4*)((GAS unsigned char*)WT + pg8::wtile_byte(drow0 + n, k0 + 8 * c, K)) = o;
        q1[j] = ((bf_lo(o.x) + bf_hi(o.x)) + (bf_lo(o.y) + bf_hi(o.y))) + ((bf_lo(o.z) + bf_hi(o.z)) + (bf_lo(o.w) + bf_hi(o.w))); q0[j] = p0;
    }
    if (gvec) {
#pragma unroll
        for (int j = 0; j < 4; ++j)
#pragma unroll
            for (int m = 1; m < 8; m <<= 1) { q1[j] += __shfl_xor(q1[j], m); q0[j] += __shfl_xor(q0[j], m); }
        const int jj = c & 3;
        const float v1 = jj == 0 ? q1[0] : jj == 1 ? q1[1] : jj == 2 ? q1[2] : q1[3], v0 = jj == 0 ? q0[0] : jj == 1 ? q0[1] : jj == 2 ? q0[2] : q0[3];
        float* dst = (c < 4 ? c1 : c0) + drow0 + (lane >> 3) + 8 * jj;
        __hip_atomic_fetch_add(dst, c < 4 ? v1 : v0, __ATOMIC_RELAXED, __HIP_MEMORY_SCOPE_AGENT);
    }
    LDS_WAIT(); asm volatile("" ::: "memory");
}

struct Args { const float* in[13]; float* out; unsigned char* ws; };

__device__ const unsigned char T5_BUCKET[3][65] = {
 {0, 1, 2, 3, 4, 5, 6, 7, 8, 8, 8, 8, 8, 8, 8, 9, 9, 9, 9, 9, 9, 9, 9, 9, 9, 9, 9, 10, 10, 10, 10, 10, 10, 10, 10, 10, 10, 10, 10, 10, 10, 10, 10, 10, 10, 10, 10, 10, 10, 10, 11, 11, 11, 11, 11, 11, 11, 11, 11, 11, 11, 11, 11, 11, 11},
 {0, 4, 8, 8, 9, 9, 9, 10, 10, 10, 10, 10, 10, 11, 11, 11, 11, 11, 11, 11, 11, 11, 11, 12, 12, 12, 12, 12, 12, 12, 12, 12, 12, 12, 12, 12, 12, 12, 12, 12, 12, 12, 13, 13, 13, 13, 13, 13, 13, 13, 13, 13, 13, 13, 13, 13, 13, 13, 13, 13, 13, 13, 13, 13, 13},
 {0, 9, 10, 10, 11, 11, 12, 12, 12, 12, 12, 13, 13, 13, 13, 13, 13, 13, 13, 13, 14, 14, 14, 14, 14, 14, 14, 14, 14, 14, 14, 14, 14, 14, 14, 15, 15, 15, 15, 15, 15, 15, 15, 15, 15, 15, 15, 15, 15, 15, 15, 15, 15, 15, 15, 15, 15, 15, 15, 15, 15, 15, 15, 15, 15}};

__device__ __forceinline__ bf16x8 pack8(const f32x4 a, const f32x4 b) {
    u32x4 w; w.x = cvt_pk_bf16(a[0], a[1]); w.y = cvt_pk_bf16(a[2], a[3]); w.z = cvt_pk_bf16(b[0], b[1]); w.w = cvt_pk_bf16(b[2], b[3]);
    return __builtin_bit_cast(bf16x8, w);
}
__device__ __forceinline__ bf16x8 join8(const u32x2 a, const u32x2 b) { u32x4 w; w.x = a.x; w.y = a.y; w.z = b.x; w.w = b.y; return __builtin_bit_cast(bf16x8, w); }

typedef short v4i16_t __attribute__((ext_vector_type(4)));
__device__ __forceinline__ u32x2 tr_read(const LAS unsigned char* p) { return __builtin_bit_cast(u32x2, __builtin_amdgcn_ds_read_tr16_b64_v4i16((LAS v4i16_t*)p)); }
__device__ __forceinline__ int swz_f(int r) { return ((r & 3) << 2) | ((r >> 2) & 3); }
__device__ __forceinline__ void glds16(const GAS void* gsrc, unsigned lds_dst) { unsigned keep;
    asm volatile("s_mov_b32 %0, m0\n\ts_mov_b32 m0, %2\n\ts_nop 0\n\tglobal_load_lds_dwordx4 %1, off\n\ts_mov_b32 m0, %0" : "=&s"(keep) : "v"(gsrc), "s"(lds_dst) : "memory"); }
__device__ __forceinline__ unsigned lds_addr(const LAS unsigned char* p) { return (unsigned)__builtin_amdgcn_readfirstlane((int)(unsigned)(size_t)p); }

struct NaU { int tok0, rows, h, r0, ks, ke; };
__device__ __forceinline__ NaU na_decode(int id) {
    NaU u; int band;
    if (id < 1024) { const int img = id >> 7, rem = id & 127; u.h = rem >> 3; band = rem & 7; u.rows = 32; u.tok0 = img * 2048; }
    else { const int i2 = id - 1024, img = i2 >> 8, rem = i2 & 255; u.h = rem >> 4; band = rem & 15; u.rows = 64; u.tok0 = PROMPT_TOK + img * 4096; }
    u.r0 = 4 * band; u.ks = imin(imax(u.r0 - 4, 0), u.rows - 8); u.ke = imin(imax(u.r0 - 1, 0), u.rows - 8) + 7; return u;
}
__device__ __forceinline__ void na_issue(LAS unsigned char* lds, const GAS bf16_t* QKV, int tok0, int h, int kr, int slot, int wave, int lane) {
    const int srow = lane >> 4, spos = lane & 15;
    const int coloff = (wave < 4 ? 2048 : 4096) + h * 128;
#pragma unroll
    for (int j = 0; j < 4; ++j) {
        const int col = 16 * (wave & 3) + 4 * j + srow;
        const GAS bf16_t* src = QKV + (size_t)(tok0 + kr * 64 + col) * 6144 + coloff + 8 * (spos ^ ((srow << 2) | j));
        glds16(src, lds_addr(lds + slot * 32768 + (16 * wave + 4 * j) * 256));
    }
}
__device__ __forceinline__ void na_tile_stage(const LAS unsigned char* slot, const LAS float* rpa, int qj, const bf16x8 (&qf)[4], f32x4 (&o)[8], float& m, float& l, int q, int g, int lane) {
    const int kb_lo = qj == 0 ? 0 : qj - 1;
    const bool three = (qj == 1) || (qj == 2);
    const int fk = swz_f(q);
    const int cq = 16 * qj + q, cs = imin(imax(cq - 8, 0), 48);
    bf16x8 kf[3][4]; float bias[3][4];
    const LAS unsigned char* kp = slot + (16 * kb_lo + q) * 256;
#pragma unroll
    for (int kbi = 0; kbi < 3; ++kbi)
#pragma unroll
        for (int kk = 0; kk < 4; ++kk) kf[kbi][kk] = *(const LAS bf16x8*)(kp + (kbi < 2 || three ? kbi : 0) * 4096 + 16 * ((4 * kk + g) ^ fk));
#pragma unroll
    for (int kbi = 0; kbi < 3; ++kbi)
#pragma unroll
        for (int e = 0; e < 4; ++e) bias[kbi][e] = rpa[imin(imax(16 * (kb_lo + kbi) + 4 * g + e - cq + 15, 0), 30)];
    __builtin_amdgcn_sched_barrier(0);
    f32x4 s[3];
#pragma unroll
    for (int kbi = 0; kbi < 3; ++kbi) { f32x4 acc = (f32x4){0.f, 0.f, 0.f, 0.f};
#pragma unroll
        for (int kk = 0; kk < 4; ++kk) acc = __builtin_amdgcn_mfma_f32_16x16x32_bf16(kf[kbi][kk], qf[kk], acc, 0, 0, 0);
        s[kbi] = acc; }
#pragma unroll
    for (int kbi = 0; kbi < 3; ++kbi) asm volatile("" : "+v"(bias[kbi][0]), "+v"(bias[kbi][1]), "+v"(bias[kbi][2]), "+v"(bias[kbi][3]));
    const int qq = q >> 2, pp = lane & 3, fv = (qq << 2) | g;
    const LAS unsigned char* vx = slot + 16384 + (16 * kb_lo + 4 * g + qq) * 256 + 8 * (pp & 1);
    u32x2 vfx[8], vfy[8];
#pragma unroll
    for (int dt = 0; dt < 8; ++dt) { const int co = 16 * ((2 * dt + (pp >> 1)) ^ fv); vfx[dt] = tr_read(vx + co); vfy[dt] = tr_read(vx + 16 * 256 + co); }
    __builtin_amdgcn_sched_barrier(0);
    float mloc = -1e30f;
#pragma unroll
    for (int kbi = 0; kbi < 3; ++kbi)
#pragma unroll
        for (int e = 0; e < 4; ++e) {
            const int ck = 16 * (kb_lo + kbi) + 4 * g + e;
            const bool valid = (kbi < 2 || three) && (ck >= cs) && (ck < cs + 16);
            const float v = valid ? s[kbi][e] * QK_SCALE2 + bias[kbi][e] : -1e30f;
            s[kbi][e] = v; mloc = fmaxf(mloc, v);
        }
    mloc = fmaxf(mloc, __shfl_xor(mloc, 16)); mloc = fmaxf(mloc, __shfl_xor(mloc, 32));
    const float mn = fmaxf(m, mloc), alpha = __builtin_amdgcn_exp2f(m - mn);
    m = mn;
    float ps = 0.f;
#pragma unroll
    for (int kbi = 0; kbi < 3; ++kbi)
#pragma unroll
        for (int e = 0; e < 4; ++e) { const float p = __builtin_amdgcn_exp2f(s[kbi][e] - mn); s[kbi][e] = p; ps += p; }
    l = l * alpha + ps;
#pragma unroll
    for (int dt = 0; dt < 8; ++dt) o[dt] = o[dt] * alpha;
    const bf16x8 pf = pack8(s[0], s[1]);
    const bf16x8 pf2 = pack8(s[2], (f32x4){0.f, 0.f, 0.f, 0.f});
    __builtin_amdgcn_sched_barrier(0);
#pragma unroll
    for (int dt = 0; dt < 8; ++dt) o[dt] = __builtin_amdgcn_mfma_f32_16x16x32_bf16(join8(vfx[dt], vfy[dt]), pf, o[dt], 0, 0, 0);
    if (three) {
#pragma unroll
        for (int dt = 0; dt < 8; ++dt) { const int co = 16 * ((2 * dt + (pp >> 1)) ^ fv); vfx[dt] = tr_read(vx + 32 * 256 + co); }
        __builtin_amdgcn_sched_barrier(0);
#pragma unroll
        for (int dt = 0; dt < 8; ++dt) o[dt] = __builtin_amdgcn_mfma_f32_16x16x32_bf16(join8(vfx[dt], vfx[dt]), pf2, o[dt], 0, 0, 0);
    }
}
__device__ __forceinline__ void na_phase(LAS unsigned char* lds, const GAS bf16_t* QKV, GAS bf16_t* O, int ldo, const float* rpb, int vcu, int G, int tid, int lane, int wave) {
    LAS float* rp = (LAS float*)(lds + 147456);
    const int q = lane & 15, g = lane >> 4;
    int idC = vcu; asm volatile("" : "+s"(idC));
    if (idC >= 2048) return;
    NaU uI = na_decode(idC); int idI = idC, krI = uI.ks; bool exI = false;
#define NA_ISSUE(slot_) do { na_issue(lds, QKV, uI.tok0, uI.h, krI, (slot_), wave, lane); \
        if (!exI) { if (krI < uI.ke) ++krI; else if (idI + G < 2048) { idI += G; uI = na_decode(idI); krI = uI.ks; } else exI = true; } } while (0)
    __syncthreads();
    NA_ISSUE(0); NA_ISSUE(1); NA_ISSUE(2);
    int gs = 0;
    for (;;) {
        const NaU u = na_decode(idC);
        const int r = u.r0 + (wave >> 1), rs_r = imin(imax(r - 4, 0), u.rows - 8), qj0 = 2 * (wave & 1);
        const GAS bf16_t* qrow = QKV + (size_t)(u.tok0 + r * 64 + 16 * qj0 + q) * 6144 + u.h * 128 + 8 * g;
        bf16x8 qf0[4], qf1[4];
#pragma unroll
        for (int kk = 0; kk < 4; ++kk) { qf0[kk] = *(const GAS bf16x8*)(qrow + 32 * kk); qf1[kk] = *(const GAS bf16x8*)(qrow + (size_t)16 * 6144 + 32 * kk); }
#pragma unroll
        for (int kk = 0; kk < 4; ++kk) asm volatile("" : "+v"(qf0[kk]), "+v"(qf1[kk]));
        asm volatile("s_barrier" ::: "memory");
        if (tid < 465) rp[tid] = rpb[u.h * 465 + tid] * LOG2E;
        f32x4 o0[8], o1[8];
#pragma unroll
        for (int dt = 0; dt < 8; ++dt) { o0[dt] = (f32x4){0.f, 0.f, 0.f, 0.f}; o1[dt] = (f32x4){0.f, 0.f, 0.f, 0.f}; }
        float m0 = -1e30f, m1 = -1e30f, l0 = 0.f, l1 = 0.f;
        for (int kr = u.ks; kr <= u.ke; ++kr) {
            asm volatile("s_waitcnt vmcnt(8) lgkmcnt(0)\n\ts_barrier" ::: "memory");
            NA_ISSUE((gs + 3) & 3);
            if (kr >= rs_r && kr < rs_r + 8) {
                const LAS unsigned char* slot = lds + (gs & 3) * 32768;
                const LAS float* rpa = rp + (kr - r + 7) * 31;
                na_tile_stage(slot, rpa, qj0, qf0, o0, m0, l0, q, g, lane);
                na_tile_stage(slot, rpa, qj0 + 1, qf1, o1, m1, l1, q, g, lane);
            }
            ++gs;
        }
        l0 += __shfl_xor(l0, 16); l0 += __shfl_xor(l0, 32); l1 += __shfl_xor(l1, 16); l1 += __shfl_xor(l1, 32);
        const float i0 = 1.0f / l0, i1 = 1.0f / l1;
        GAS bf16_t* orow = O + (size_t)(u.tok0 + r * 64 + 16 * qj0 + q) * ldo + u.h * 128 + 4 * g;
#pragma unroll
        for (int dt = 0; dt < 8; ++dt) { const f32x4 v0 = o0[dt] * i0, v1 = o1[dt] * i1; u32x2 w0, w1; w0.x = cvt_pk_bf16(v0[0], v0[1]); w0.y = cvt_pk_bf16(v0[2], v0[3]); w1.x = cvt_pk_bf16(v1[0], v1[1]); w1.y = cvt_pk_bf16(v1[2], v1[3]);
            *(GAS u32x2*)(orow + 16 * dt) = w0; *(GAS u32x2*)(orow + (size_t)16 * ldo + 16 * dt) = w1; }
        idC += G; if (idC >= 2048) break;
    }
#undef NA_ISSUE
    asm volatile("s_waitcnt vmcnt(0)" ::: "memory");
    __syncthreads();
}

struct DilU { int btok0, grp, sh, L, rho, l0b, h; };
__device__ __forceinline__ DilU dil_decode(int id) {
    DilU u; const int gh = id >> 8, pb = id & 255; u.grp = gh >> 3; u.h = gh & 7; u.sh = 2 * u.grp;
    int T, pp;
    if (pb < 128) { T = 2048; u.btok0 = (pb >> 4) * 2048; pp = (pb & 15) * 128; }
    else { T = 4096; u.btok0 = PROMPT_TOK + ((pb - 128) >> 5) * 4096; pp = ((pb - 128) & 31) * 128; }
    u.L = T >> u.sh; u.rho = pp / u.L; u.l0b = pp - u.rho * u.L; return u;
}
__device__ __forceinline__ void dil_stage(LAS unsigned char* tile, const GAS bf16_t* QKV, const DilU& u, int coloff, int wave, int lane) {
    const int srow = lane >> 4, spos = lane & 15;
#pragma unroll
    for (int i = 0; i < 8; ++i) {
        const int trow = 32 * wave + 4 * i + srow;
        const int lk = imin(imax(u.l0b - 64 + trow, 0), u.L - 1);
        glds16(QKV + (size_t)(u.btok0 + (lk << u.sh) + u.rho) * 9216 + u.grp * 3072 + u.h * 128 + coloff + 8 * (spos ^ swz_f(trow)), lds_addr(tile + (32 * wave + 4 * i) * 256));
    }
}
__device__ __forceinline__ void dil_bias(LAS float* bt, const float* relb, const DilU& u, int tid) {
    if (tid < 131) { const int rel = tid - 65, mag = rel < 0 ? -rel : rel; const int bucket = (rel > 0 ? 16 : 0) + T5_BUCKET[u.grp][mag > 64 ? 64 : mag];
        const float bv = relb[bucket * 24 + u.grp * 8 + u.h] * LOG2E;
        bt[tid] = (tid == 0 || tid == 130) ? -1e30f : bv; }
}
__device__ __forceinline__ void dil_phase(LAS unsigned char* lds, const GAS bf16_t* QKV, GAS bf16_t* O, int ldo, int gstride, GAS float* LSE, const float* relb, int vcu, int G, int tid, int lane, int wave) {
    LAS float* bt = (LAS float*)(lds + 147456);
    const int q = lane & 15, g = lane >> 4;
    int id = vcu; asm volatile("" : "+s"(id));
    if (id >= 6144) return;
    DilU u = dil_decode(id);
    __syncthreads();
    dil_bias(bt, relb, u, tid);
    dil_stage(lds, QKV, u, 1024, wave, lane);
#define DIL_QLOAD(dst_, uu_) do { const int tq_ = (uu_).btok0 + (((uu_).l0b + 16 * wave + q) << (uu_).sh) + (uu_).rho; const GAS bf16_t* qp_ = QKV + (size_t)tq_ * 9216 + (uu_).grp * 3072 + (uu_).h * 128 + 8 * g; \
        _Pragma("unroll") for (int kk = 0; kk < 4; ++kk) dst_[kk] = *(const GAS bf16x8*)(qp_ + 32 * kk); } while (0)
    bf16x8 qn[4]; DIL_QLOAD(qn, u);
    {
        volatile GAS float* lp = (volatile GAS float*)LSE + (size_t)(u.btok0 + ((u.l0b + 16 * wave + q) << u.sh) + u.rho) * 24 + u.grp * 8 + u.h;
#pragma unroll
        for (int i = 0; i < 8; ++i) *lp = 0.f;
    }
    for (;;) {
        const int l0 = u.l0b + 16 * wave;
        const int tq = u.btok0 + ((l0 + q) << u.sh) + u.rho;
        asm volatile("s_waitcnt vmcnt(8) lgkmcnt(0)\n\ts_barrier" ::: "memory");
        bf16x8 qf[4];
#pragma unroll
        for (int kk = 0; kk < 4; ++kk) { qf[kk] = qn[kk]; asm volatile("" : "+v"(qf[kk])); }
        dil_stage(lds + 65536, QKV, u, 2048, wave, lane);
        const int fk = swz_f(q);
        f32x4 s[10];
#pragma unroll
        for (int kb3 = 0; kb3 < 3; ++kb3) {
            bf16x8 kf[3][4];
#pragma unroll
            for (int j = 0; j < 3; ++j)
#pragma unroll
                for (int kk = 0; kk < 4; ++kk) kf[j][kk] = *(const LAS bf16x8*)(lds + (16 * wave + 16 * (3 * kb3 + j) + q) * 256 + 16 * ((4 * kk + g) ^ fk));
            __builtin_amdgcn_sched_barrier(0);
#pragma unroll
            for (int j = 0; j < 3; ++j) { f32x4 acc = (f32x4){0.f, 0.f, 0.f, 0.f};
#pragma unroll
                for (int kk = 0; kk < 4; ++kk) acc = __builtin_amdgcn_mfma_f32_16x16x32_bf16(kf[j][kk], qf[kk], acc, 0, 0, 0);
                s[3 * kb3 + j] = acc; }
            __builtin_amdgcn_sched_barrier(0);
        }
        s[9] = (f32x4){0.f, 0.f, 0.f, 0.f};
        float mx = -1e30f;
        const bool edge = !((l0 >= 64) && (l0 + 79 < u.L));
#pragma unroll
        for (int kb = 0; kb < 9; ++kb) {
            float bias[4];
#pragma unroll
            for (int e = 0; e < 4; ++e) bias[e] = bt[imin(imax(16 * kb + 4 * g + e - q + 1, 0), 130)];
            asm volatile("" : "+v"(bias[0]), "+v"(bias[1]), "+v"(bias[2]), "+v"(bias[3]));
            if (!edge) {
#pragma unroll
                for (int e = 0; e < 4; ++e) { const float v = s[kb][e] * QK_SCALE2 + bias[e]; s[kb][e] = v; mx = fmaxf(mx, v); }
            } else {
#pragma unroll
                for (int e = 0; e < 4; ++e) {
                    const int lkey = l0 - 64 + 16 * kb + 4 * g + e;
                    const bool valid = (lkey >= 0) && (lkey < u.L);
                    const float v = valid ? s[kb][e] * QK_SCALE2 + bias[e] : -1e30f;
                    s[kb][e] = v; mx = fmaxf(mx, v);
                }
            }
        }
        mx = fmaxf(mx, __shfl_xor(mx, 16)); mx = fmaxf(mx, __shfl_xor(mx, 32));
        float sum = 0.f;
#pragma unroll
        for (int kb = 0; kb < 9; ++kb)
#pragma unroll
            for (int e = 0; e < 4; ++e) { const float p = __builtin_amdgcn_exp2f(s[kb][e] - mx); s[kb][e] = p; sum += p; }
        sum += __shfl_xor(sum, 16); sum += __shfl_xor(sum, 32);
        const float inv = 1.0f / sum;
        if (g == 0) LSE[(size_t)tq * 24 + u.grp * 8 + u.h] = mx + __builtin_amdgcn_logf(sum);
        asm volatile("s_barrier" ::: "memory");
        const int idn = id + G; const bool hn = idn < 6144;
        const DilU un = hn ? dil_decode(idn) : u;
        dil_bias(bt, relb, un, tid);
        dil_stage(lds, QKV, un, 1024, wave, lane);
        DIL_QLOAD(qn, un);
        asm volatile("s_waitcnt vmcnt(12)\n\ts_barrier" ::: "memory");
        f32x4 o[8];
#pragma unroll
        for (int dt = 0; dt < 8; ++dt) o[dt] = (f32x4){0.f, 0.f, 0.f, 0.f};
        const int qq = q >> 2, pp = lane & 3, fv = (qq << 2) | g;
        const LAS unsigned char* vlane = lds + 65536 + (16 * wave + 4 * g + qq) * 256 + 8 * (pp & 1);
#pragma unroll
        for (int c = 0; c < 5; ++c) {
            const bf16x8 pf = pack8(s[2 * c], s[2 * c + 1]);
            const LAS unsigned char* vx = vlane + (32 * c) * 256;
            const int yo = (c == 4) ? 0 : 16 * 256;
            u32x2 vfx[8], vfy[8];
#pragma unroll
            for (int dt = 0; dt < 8; ++dt) { const int co = 16 * ((2 * dt + (pp >> 1)) ^ fv); vfx[dt] = tr_read(vx + co); vfy[dt] = tr_read(vx + yo + co); }
            __builtin_amdgcn_sched_barrier(0);
#pragma unroll
            for (int dt = 0; dt < 8; ++dt) o[dt] = __builtin_amdgcn_mfma_f32_16x16x32_bf16(join8(vfx[dt], vfy[dt]), pf, o[dt], 0, 0, 0);
            __builtin_amdgcn_sched_barrier(0);
        }
        GAS bf16_t* orow = O + (size_t)tq * ldo + u.grp * gstride + u.h * 128;
#pragma unroll
        for (int dt = 0; dt < 8; ++dt) { const f32x4 v = o[dt] * inv; u32x2 w; w.x = cvt_pk_bf16(v[0], v[1]); w.y = cvt_pk_bf16(v[2], v[3]);
            *(GAS u32x2*)(orow + 16 * dt + 4 * g) = w; }
        if (!hn) break;
        u = un; id = idn;
    }
    asm volatile("s_waitcnt vmcnt(0)" ::: "memory");
    __syncthreads();
#undef DIL_QLOAD
}

__device__ __forceinline__ void group_sync(unsigned* bar, unsigned* cnt, unsigned target, bool leader) {
    asm volatile("s_waitcnt vmcnt(0)" ::: "memory");
    __syncthreads();
    if (leader) {
        __builtin_amdgcn_fence(__ATOMIC_RELEASE, "agent");
        asm volatile("s_waitcnt vmcnt(0)" ::: "memory");
        (void)xb_add(cnt, 1u);
        XB_SPIN(xb_ld(cnt) < target, bar);
        __builtin_amdgcn_fence(__ATOMIC_ACQUIRE, "agent");
        asm volatile("s_waitcnt vmcnt(0)" ::: "memory");
    }
    __syncthreads();
}

__global__ void __launch_bounds__(NWAVES * 64, 2) fwd(Args args) {
    extern __shared__ __attribute__((aligned(16))) unsigned char lds_raw[];
    LAS unsigned char* lds = (LAS unsigned char*)lds_raw;
    volatile LAS unsigned* MISC = (volatile LAS unsigned*)(lds + MISC_OFF);
    const int G = gridDim.x, bx = blockIdx.x;
    const int vcu = (G % 8 == 0) ? (bx % 8) * (G / 8) + bx / 8 : bx;
    const int NGW = G * NWAVES;
    const int wave_k = __builtin_amdgcn_readfirstlane((int)threadIdx.x >> 6);
    { const int t0 = threadIdx.x; for (int u = t0; u < (LDS_BYTES - CTLZ_OFF) / 4; u += NWAVES * 64) ((LAS unsigned*)(lds + CTLZ_OFF))[u] = 0u; }
    __syncthreads();
    xcd_barrier_post((unsigned*)(args.ws + WS_CTL) + CW_BAR);
    unsigned idle_ticks = 0u; (void)idle_ticks;
#define GRID_BAR() do { GAS unsigned* bg_ = (GAS unsigned*)(args.ws + WS_CTL) + CW_BAR; asm volatile("" : "+s"(bg_)); unsigned* b_ = (unsigned*)bg_; int w_ = wave_k; asm volatile("" : "+s"(w_)); \
    const bool ld_ = (w_ == 0) && (lane_id_fresh() == 0); const unsigned long long tb0_ = PROBE_IDLE ? __builtin_amdgcn_s_memrealtime() : 0ull; xcd_barrier(b_, MISC + 8, ld_); if (PROBE_IDLE) idle_ticks += (unsigned)(__builtin_amdgcn_s_memrealtime() - tb0_); } while (0)
    unsigned gs_round = 0u;
#define GROUP_SYNC() do { GAS unsigned* bg_ = (GAS unsigned*)(args.ws + WS_CTL) + CW_BAR; asm volatile("" : "+s"(bg_)); unsigned* b_ = (unsigned*)bg_; int w_ = wave_k; asm volatile("" : "+s"(w_)); \
    const bool ld_ = (w_ == 0) && (lane_id_fresh() == 0); gs_round += 1u; const unsigned long long tb0_ = PROBE_IDLE ? __builtin_amdgcn_s_memrealtime() : 0ull; \
    group_sync(b_, b_ + CW_GRP + 32 * (vcu / pg8::GS), gs_round * (unsigned)pg8::GS, ld_); if (PROBE_IDLE) idle_ticks += (unsigned)(__builtin_amdgcn_s_memrealtime() - tb0_); } while (0)
#define PHASE_LOCALS() const int lane = lane_id_fresh(); int wave = wave_k; asm volatile("" : "+s"(wave)); \
    const int tid = wave * 64 + lane; const int gw = vcu * NWAVES + wave; \
    GAS unsigned char* wsg_ = (GAS unsigned char*)args.ws; asm volatile("" : "+s"(wsg_)); unsigned char* ws = (unsigned char*)wsg_; GAS float* outg_ = (GAS float*)args.out; asm volatile("" : "+s"(outg_)); float* out = (float*)outg_; (void)tid; (void)gw; (void)out; \
    bf16_t* WGU = (bf16_t*)(ws + WS_WGU); bf16_t* WD = (bf16_t*)(ws + WS_WD); bf16_t* NAQKV = (bf16_t*)(ws + WS_NAQKV); bf16_t* NAO = (bf16_t*)(ws + WS_NAO); \
    bf16_t* DQKV = (bf16_t*)(ws + WS_DQKV); bf16_t* DOW = (bf16_t*)(ws + WS_DO); bf16_t* XB = (bf16_t*)(ws + WS_XB); bf16_t* BIG = (bf16_t*)(ws + WS_BIG); \
    float* LSE = (float*)(ws + WS_LSE); unsigned char* YLO = (unsigned char*)(ws + WS_YLO); (void)YLO; float* STATS = (float*)(ws + WS_STATS); float* C1 = (float*)(ws + WS_C1); float* C0 = (float*)(ws + WS_C0); (void)STATS; (void)C1; (void)C0; (void)WGU; (void)WD; (void)NAQKV; (void)NAO; (void)DQKV; (void)DOW; (void)XB; (void)BIG; (void)LSE;

    for (int rep = PROBE_P0 - 1; rep >= 0; --rep) {
        PHASE_LOCALS();
        if (rep) { C1 = (float*)(ws + WS_END); C0 = C1 + 12 * CSTRIDE; }
        LAS float* scr = (LAS float*)(lds + wave * 16384);
        constexpr int NFFN = 24 * 5632, NNAQ = 2 * 6144, NNAO = 2 * 2048, NDQ = 2 * 9216, NDO = 2 * 1024;
        constexpr int NITEMS = NFFN + NNAQ + NNAO + NDQ + NDO;
        for (int it = gw; it < NITEMS; it += NGW) {
            int r = it;
            if (r < NFFN) {
                const int m = r / 5632, rr = r - m * 5632, f = m / 3, kind = m - 3 * f;
                if (kind < 2) { const int kb = rr / 176, nb = rr - kb * 176, n0 = nb * 32;
                    const int slc = 3 * (f >> 1) + 2 * (f & 1);
                    transpose_item(args.in[4 + kind] + (size_t)f * DM * DFF, DM, DFF, WGU + (size_t)f * 2 * DFF * DM, (n0 >> 7) * 256 + (n0 & 127) + kind * 128, kb * 64, n0, scr, lane,
                                   slc ? args.in[2] + (size_t)(slc - 1) * DM : nullptr, args.in[3] + (size_t)(slc ? slc - 1 : 0) * DM, C1 + (size_t)slc * CSTRIDE, C0 + (size_t)slc * CSTRIDE, kind == 0 ? -LOG2E : 1.0f); }
                else { const int kb = rr / 64, nb = rr - kb * 64, n0 = nb * 32;
                    transpose_item(args.in[6] + (size_t)f * DFF * DM, DFF, DM, WD + (size_t)f * DM * DFF, n0, kb * 64, n0, scr, lane, nullptr, nullptr, nullptr, nullptr); }
                continue;
            }
            r -= NFFN;
            if (r < NNAQ) { const int j = r / 6144, rr = r - j * 6144, kb = rr / 192, nb = rr - kb * 192, n0 = nb * 32;
                transpose_item(args.in[7] + (size_t)j * DM * 6144, DM, 6144, NAQKV + (size_t)j * 6144 * DM, n0, kb * 64, n0, scr, lane, args.in[2] + (size_t)(6 * j) * DM, args.in[3] + (size_t)(6 * j) * DM, C1 + (size_t)(6 * j + 1) * CSTRIDE, C0 + (size_t)(6 * j + 1) * CSTRIDE); continue; }
            r -= NNAQ;
            if (r < NNAO) { const int j = r / 2048, rr = r - j * 2048, kb = rr / 64, nb = rr - kb * 64, n0 = nb * 32;
                transpose_item(args.in[8] + (size_t)j * DM * DM, DM, DM, NAO + (size_t)j * DM * DM, n0, kb * 64, n0, scr, lane, nullptr, nullptr, nullptr, nullptr); continue; }
            r -= NNAO;
            if (r < NDQ) { const int j = r / 9216, rr = r - j * 9216, kb = rr / 288, nb = rr - kb * 288, n0 = nb * 32;
                transpose_item(args.in[10] + (size_t)j * DM * 9216, DM, 9216, DQKV + (size_t)j * 9216 * DM, n0, kb * 64, n0, scr, lane, args.in[2] + (size_t)(6 * j + 3) * DM, args.in[3] + (size_t)(6 * j + 3) * DM, C1 + (size_t)(6 * j + 4) * CSTRIDE, C0 + (size_t)(6 * j + 4) * CSTRIDE); continue; }
            r -= NDQ;
            { const int j = r / 1024, rr = r - j * 1024, kb = rr / 64, nb = rr - kb * 64, n0 = nb * 32;
                transpose_item(args.in[11] + (size_t)j * 1024 * DM, 1024, DM, DOW + (size_t)j * DM * 1024, n0, kb * 64, n0, scr, lane, nullptr, nullptr, nullptr, nullptr); }
        }
        {
            const int wr = wave >> 2, wc = wave & 3, fr = lane & 15, fq = lane >> 4;
            for (int t = vcu; t < (MTOK / 256) * 8; t += G) {
                const int pm = t >> 3, pn = t & 7, row0 = pm * 256 + wr * 64 + fr, col0 = pn * 256 + wc * 32 + 8 * fq;
                const float* src = (row0 < PROMPT_TOK ? args.in[0] + (size_t)row0 * DM : args.in[1] + (size_t)(row0 - PROMPT_TOK) * DM) + col0;
                unsigned char* lrec = YLO + lo_rec(pm, pn, wr, wc, fr, fq);
#pragma unroll
                for (int i = 0; i < 8; ++i) { const size_t ro = (size_t)((i >> 2) * 128 + (i & 3) * 16) * DM; u32x4 lq;
#pragma unroll
                    for (int bj = 0; bj < 2; ++bj) { const f32x4 y0 = *(const GAS f32x4*)(src + ro + bj * 128), y1 = *(const GAS f32x4*)(src + ro + bj * 128 + 4);
                        u32x4 h; h.x = cvt_pk_bf16(y0[0], y0[1]); h.y = cvt_pk_bf16(y0[2], y0[3]); h.z = cvt_pk_bf16(y1[0], y1[1]); h.w = cvt_pk_bf16(y1[2], y1[3]);
                        const unsigned l0 = lo8_pack4(y0[0] - bf_lo(h.x), y0[1] - bf_hi(h.x), y0[2] - bf_lo(h.y), y0[3] - bf_hi(h.y)), l1 = lo8_pack4(y1[0] - bf_lo(h.z), y1[1] - bf_hi(h.z), y1[2] - bf_lo(h.w), y1[3] - bf_hi(h.w));
                        *(GAS u32x4*)((GAS unsigned char*)XB + pg8::atile_byte(row0 + (i >> 2) * 128 + (i & 3) * 16, col0 + bj * 128, DM)) = h; if (bj == 0) { lq.x = l0; lq.y = l1; } else { lq.z = l0; lq.w = l1; } }
                    *(GAS u32x4*)(lrec + i * 1024) = lq; }
            }
        }
    }
    GRID_BAR();

    for (int sl = 0; sl < 12; ++sl) {
        const int li = sl / 3, kind = sl - 3 * li;
        PHASE_LOCALS();
        const bf16_t* Ares; int lda_res, Kres; const bf16_t* Wres; float sres;
        const float* stats_old = sl ? STATS + (size_t)(sl - 1) * MTOK * 2 : nullptr;
        const pg8::LnFold FOLD{stats_old, C1 + (size_t)sl * CSTRIDE, C0 + (size_t)sl * CSTRIDE};
        bf16_t* SCR = (bf16_t*)(ws + WS_END); (void)SCR;
        if (kind != 1) {
            const int f = li * 2 + (kind >> 1);
            for (int rep = 0; rep < PROBE_GU; ++rep) {
            { pg8::Gemm g{XB, DM, DM, 1}; pg8::BPlain B{WGU + (size_t)f * 2 * DFF * DM, DM}; pg8::PanelOrder S; S.init(MTOK, 2 * DFF, G, vcu); pg8::EpiSwiGLU E{BIG, DFF, FOLD};
              pg8::gemm_phase<pg8::EpiSwiGLU, pg8::BPlain, pg8::PanelOrder>(lds, g, B, S, E, tid); }
            GROUP_SYNC();
            }
            Ares = BIG; lda_res = DFF; Kres = DFF; Wres = WD + (size_t)f * DM * DFF; sres = 0.5f * -0.6931471805599453f;
        } else if ((li & 1) == 0) {
            const int j = li >> 1;
            bf16_t* QKVB = BIG;
            for (int rep = 0; rep < PROBE_QKV; ++rep) {
            { pg8::Gemm g{XB, DM, DM, 1}; pg8::BPlain B{NAQKV + (size_t)j * 6144 * DM, DM}; pg8::PanelOrder S; S.init(MTOK, 6144, G, vcu); pg8::EpiBf16P E{QKVB, 6144, FOLD};
              pg8::gemm_phase<pg8::EpiBf16P, pg8::BPlain, pg8::PanelOrder>(lds, g, B, S, E, tid); }
            GRID_BAR();
            }
            for (int rep = PROBE_ATT - 1; rep >= 0; --rep) {
                const float* rpb = args.in[9] + (size_t)j * 16 * 465;
                GAS bf16_t* O = rep ? (GAS bf16_t*)SCR : (GAS bf16_t*)out; const int ldo = 2048;
                na_phase(lds, (const GAS bf16_t*)QKVB, O, ldo, rpb, vcu, G, tid, lane, wave);
                GRID_BAR();
            }
            Ares = (const bf16_t*)out; lda_res = 2048; Kres = DM; Wres = NAO + (size_t)j * DM * DM; sres = 1.0f;
        } else {
            const int j = li >> 1;
            bf16_t* QKVB = BIG;
            for (int rep = 0; rep < PROBE_QKV; ++rep) {
            { pg8::Gemm g{XB, DM, DM, 1}; pg8::BPlain B{DQKV + (size_t)j * 9216 * DM, DM}; pg8::PanelOrder S; S.init(MTOK, 9216, G, vcu); pg8::EpiBf16P E{QKVB, 9216, FOLD};
              pg8::gemm_phase<pg8::EpiBf16P, pg8::BPlain, pg8::PanelOrder>(lds, g, B, S, E, tid); }
            GRID_BAR();
            }
            for (int rep = PROBE_ATT - 1; rep >= 0; --rep) {
                GAS bf16_t* O = rep ? (GAS bf16_t*)SCR : (GAS bf16_t*)QKVB; const int ldo = rep ? 3072 : 9216, gstride = rep ? 1024 : 3072;
                dil_phase(lds, (const GAS bf16_t*)QKVB, O, ldo, gstride, (GAS float*)LSE, args.in[12], vcu, G, tid, lane, wave);
                GRID_BAR();
            }
            for (int rep = PROBE_ATT - 1; rep >= 0; --rep) {
            GAS bf16_t* MO = rep ? (GAS bf16_t*)SCR : (GAS bf16_t*)out; const int ldm = 1024;
            for (int tok = gw; tok < MTOK; tok += NGW) {
                const int h = lane >> 3, c16 = (lane & 7) * 16;
                const GAS float* lp = (const GAS float*)LSE + (size_t)tok * 24 + h;
                const float l0 = lp[0], l1 = lp[8], l2 = lp[16];
                const float m = fmaxf(l0, fmaxf(l1, l2));
                float w0 = __builtin_amdgcn_exp2f(l0 - m), w1 = __builtin_amdgcn_exp2f(l1 - m), w2 = __builtin_amdgcn_exp2f(l2 - m);
                const float inv = 1.0f / (w0 + w1 + w2); w0 *= inv; w1 *= inv; w2 *= inv;
                const GAS bf16_t* base = (const GAS bf16_t*)QKVB + (size_t)tok * 9216 + h * 128 + c16;
                GAS bf16_t* obase = MO + (size_t)tok * ldm + h * 128 + c16;
#pragma unroll
                for (int hf = 0; hf < 2; ++hf) {
                    const u32x4 a0 = *(const GAS u32x4*)(base + hf * 8), a1 = *(const GAS u32x4*)(base + 3072 + hf * 8), a2 = *(const GAS u32x4*)(base + 6144 + hf * 8);
                    u32x4 w;
#pragma unroll
                    for (int k = 0; k < 4; ++k) {
                        const float lo = w0 * bf_lo(a0[k]) + w1 * bf_lo(a1[k]) + w2 * bf_lo(a2[k]);
                        const float hi = w0 * bf_hi(a0[k]) + w1 * bf_hi(a1[k]) + w2 * bf_hi(a2[k]);
                        w[k] = cvt_pk_bf16(lo, hi);
                    }
                    *(GAS u32x4*)(obase + hf * 8) = w;
                }
            }
            GRID_BAR();
            }
            Ares = (const bf16_t*)out; lda_res = 1024; Kres = 1024; Wres = DOW + (size_t)j * DM * 1024; sres = 1.0f;
        }
#if PROBE_RESK == 4
        { pg8::Gemm g{Ares, lda_res, Kres, kind != 1 ? 1 : 0}; pg8::BPlain B{Wres, Kres}; pg8::StaticOrder S; S.init(MTOK, DM, G, bx);
          pg8::EpiResidLn E{XB, YLO, DM, ALPHA, sres, stats_old, args.in[2] + (size_t)(sl ? sl - 1 : 0) * DM, args.in[3] + (size_t)(sl ? sl - 1 : 0) * DM, (float*)SCR};
          E.YHo = (bf16_t*)out; E.YLo = (unsigned char*)out + (size_t)MTOK * DM * 2;
          pg8::gemm_phase<pg8::EpiResidLn, pg8::BPlain, pg8::StaticOrder>(lds, g, B, S, E, tid); GRID_BAR(); }
#endif
        for (int rep = 0; rep < ((PROBE_RESK && PROBE_RESK != 4) ? 1 : 0); ++rep) { pg8::Gemm g{Ares, lda_res, Kres, kind != 1 ? 1 : 0}; pg8::BPlain B{Wres, Kres}; pg8::StaticOrder S; S.init(MTOK, DM, G, bx); pg8::EpiNull E{out, SCR};
          pg8::gemm_phase<pg8::EpiNull, pg8::BPlain, pg8::StaticOrder>(lds, g, B, S, E, tid); GRID_BAR(); }
        if (STAG_US) { const unsigned long long t0 = __builtin_amdgcn_s_memrealtime(), dl = (unsigned long long)((vcu & 3) * STAG_US * 100);
          while (__builtin_amdgcn_s_memrealtime() - t0 < dl) __builtin_amdgcn_s_sleep(8);
          __syncthreads(); }
        { pg8::Gemm g{Ares, lda_res, Kres, kind != 1 ? 1 : 0}; pg8::BPlain B{Wres, Kres}; pg8::PanelOrder S; S.init(MTOK, DM, G, vcu);
          pg8::EpiResidLn E{XB, YLO, DM, ALPHA, sres, stats_old, args.in[2] + (size_t)(sl ? sl - 1 : 0) * DM, args.in[3] + (size_t)(sl ? sl - 1 : 0) * DM, STATS + (size_t)sl * MTOK * 2};
          pg8::gemm_phase<pg8::EpiResidLn, pg8::BPlain, pg8::PanelOrder>(lds, g, B, S, E, tid); }
        if (kind == 0 || sl == 11) GRID_BAR(); else GROUP_SYNC();
    }
    {
        PHASE_LOCALS();
#if PROBE_IDLE
        if (tid == 0) atomicAdd((unsigned*)(ws + WS_CTL) + 64, idle_ticks);
        GRID_BAR();
#endif
        {
            const int wr = wave >> 2, wc = wave & 3, fr = lane & 15, fq = lane >> 4;
            const pg8::LnFold Fin{STATS + (size_t)11 * MTOK * 2, nullptr, nullptr};
            const float* g11 = args.in[2] + (size_t)11 * DM; const float* b11 = args.in[3] + (size_t)11 * DM;
            for (int t = vcu; t < (MTOK / 256) * 8; t += G) {
                const int pm = t >> 3, pn = t & 7, row0 = pm * 256 + wr * 64 + fr, col0 = pn * 256 + wc * 32 + 8 * fq;
                const unsigned char* lrec = YLO + lo_rec(pm, pn, wr, wc, fr, fq);
                f32x4 gv[2][2], bv[2][2];
#pragma unroll
                for (int bj = 0; bj < 2; ++bj)
#pragma unroll
                    for (int n = 0; n < 2; ++n) { gv[bj][n] = *(const GAS f32x4*)(g11 + col0 + bj * 128 + 4 * n); bv[bj][n] = *(const GAS f32x4*)(b11 + col0 + bj * 128 + 4 * n); }
#pragma unroll
                for (int i = 0; i < 8; ++i) { const int row = row0 + (i >> 2) * 128 + (i & 3) * 16;
                    float mu, rstd; Fin.row(row, mu, rstd);
                    const u32x4 L = *(const GAS u32x4*)(lrec + i * 1024);
#pragma unroll
                    for (int bj = 0; bj < 2; ++bj) { const u32x4 h = *(const GAS u32x4*)((const GAS unsigned char*)XB + pg8::atile_byte(row, col0 + bj * 128, DM));
                        const f32x4 y0 = (f32x4){bf_lo(h.x), bf_hi(h.x), bf_lo(h.y), bf_hi(h.y)} + lo8_unpack4(bj ? L.z : L.x), y1 = (f32x4){bf_lo(h.z), bf_hi(h.z), bf_lo(h.w), bf_hi(h.w)} + lo8_unpack4(bj ? L.w : L.y);
                        GAS f32x4* op = (GAS f32x4*)(out + (size_t)row * DM + col0 + bj * 128);
                        op[0] = (y0 - mu) * (gv[bj][0] * rstd) + bv[bj][0]; op[1] = (y1 - mu) * (gv[bj][1] * rstd) + bv[bj][1]; } }
            }
        }
#if PROBE_IDLE
        if (bx == 0 && tid == 0) { asm volatile("s_waitcnt vmcnt(0)" ::: "memory"); const unsigned tot = __hip_atomic_load((unsigned*)(ws + WS_CTL) + 64, __ATOMIC_RELAXED, __HIP_MEMORY_SCOPE_AGENT); out[0] += (float)tot / (float)G * 1e-4f; }
#endif
    }
#undef GRID_BAR
}

extern "C" void kernel_launch(void* const* d_in, const int* in_sizes, int n_in, void* d_out, int out_size, void* d_ws, size_t ws_size, hipStream_t stream) {
    static int grid = 0;
    if (grid == 0) {
        if (n_in != 13 || out_size != MTOK * DM || ws_size < WS_END + (size_t)((PROBE_ATT > 1) ? (size_t)MTOK * 3072 * 2 : 0)) { fprintf(stderr, "kernel_launch: unexpected shapes (n_in %d, out %d, ws %zu < %zu); nothing launched\n", n_in, out_size, ws_size, (size_t)WS_END); grid = -1; return; }
        int dev = 0, cus = 0, per_cu = 0;
        if (hipGetDevice(&dev) != hipSuccess || hipDeviceGetAttribute(&cus, hipDeviceAttributeMultiprocessorCount, dev) != hipSuccess) { grid = -1; return; }
        if (hipFuncSetAttribute((const void*)fwd, hipFuncAttributeMaxDynamicSharedMemorySize, LDS_BYTES) != hipSuccess) { fprintf(stderr, "kernel_launch: hipFuncSetAttribute failed\n"); grid = -1; return; }
        if (hipOccupancyMaxActiveBlocksPerMultiprocessor(&per_cu, (const void*)fwd, NWAVES * 64, LDS_BYTES) != hipSuccess || per_cu < 1)
            fprintf(stderr, "kernel_launch: note: occupancy query reports %d workgroups per CU\n", per_cu);
        (void)hipGetLastError();
        if (cus < 256) { fprintf(stderr, "kernel_launch: %d CUs; the row-panel ownership needs 256 resident workgroups; nothing launched\n", cus); grid = -1; return; }
        grid = 256;
    }
    if (grid < 0) return;
    if (hipMemsetAsync((char*)d_ws + WS_CTL, 0, CTL_ZERO_BYTES, stream) != hipSuccess) { fprintf(stderr, "kernel_launch: memset failed\n"); return; }
    Args a{};
    for (int i = 0; i < 13; ++i) a.in[i] = (const float*)d_in[i];
    a.out = (float*)d_out; a.ws = (unsigned char*)d_ws;
    hipLaunchKernelGGL(fwd, dim3(grid), dim3(NWAVES * 64), LDS_BYTES, stream, a);
    const hipError_t le = hipPeekAtLastError();
    if (le != hipSuccess) fprintf(stderr, "kernel_launch: launch failed: %s\n", hipGetErrorName(le));
}
```
